# Optimizing an MI355X kernel written in HIP

```python
import jax
import jax.numpy as jnp
from jax import lax
import numpy as np

D_MODEL = 2048
BATCH = 1
SEQ = 8192
DEPTH = 2

GRID_W = 64
CTX_LEN = 256
HEAD_DIM = 128
MIX_W = D_MODEL // 2
POOL_GROUPS = 4
POOL_WINDOWS = (2, 4, 8, 16)
POOL_GROUP_W = MIX_W // POOL_GROUPS
G_Q_HEADS = MIX_W // HEAD_DIM
G_KV_HEADS = 2
W_Q_HEADS = MIX_W // HEAD_DIM
W_KV_HEADS = 2
WINDOW = 128
Q_BLOCK = 128
N_BRANCH = 3
ROPE_THETA = 10000.0
N_EXPERTS = 32
N_GROUPS = 4
EXPERTS_PER_GROUP = N_EXPERTS // N_GROUPS
TOP_K = 2
EXPERT_FF = D_MODEL // 2
MOE_BLOCK = 128
RMS_EPS = 1e-6
NEG_INF = -1e30
ATTN_SCALE = HEAD_DIM ** -0.5

OFF_GQ = MIX_W
OFF_GK = OFF_GQ + G_Q_HEADS * HEAD_DIM
OFF_GV = OFF_GK + G_KV_HEADS * HEAD_DIM
OFF_WQ = OFF_GV + G_KV_HEADS * HEAD_DIM
OFF_WK = OFF_WQ + W_Q_HEADS * HEAD_DIM
OFF_WV = OFF_WK + W_KV_HEADS * HEAD_DIM
OFF_GATE = OFF_WV + W_KV_HEADS * HEAD_DIM
IN_WIDTH = OFF_GATE + N_BRANCH * D_MODEL

kernel_name = 'hybrid_pool_gqa_swa_moe_dit'


def rmsnorm(x, g):
    xf = x.astype(jnp.float32)
    y = xf * lax.rsqrt(jnp.mean(xf * xf, axis=-1, keepdims=True) + RMS_EPS)
    return (y * g.astype(jnp.float32)).astype(x.dtype)


def modulate(h, shift, scale):
    return h * (1 + scale[:, None, :]) + shift[:, None, :]


def as_q(t, n_kv):
    B, L, _ = t.shape
    return t.reshape(B, L, n_kv, -1, HEAD_DIM)


def as_kv(t):
    B, L, _ = t.shape
    return t.reshape(B, L, -1, HEAD_DIM)


def proj_cols(h, w, a, b):
    return jnp.einsum('bld,de->ble', h, w[:, a:b])


def axial_rope_tables(rows):
    row_ids = jnp.repeat(jnp.arange(rows, dtype=jnp.float32), GRID_W)
    col_ids = jnp.tile(jnp.arange(GRID_W, dtype=jnp.float32), rows)
    n_freq = HEAD_DIM // 4
    inv = ROPE_THETA ** (-jnp.arange(n_freq, dtype=jnp.float32) / n_freq)
    ar = row_ids[:, None] * inv
    ac = col_ids[:, None] * inv
    ang = jnp.concatenate([ar, ar, ac, ac], axis=-1)
    return jnp.cos(ang), jnp.sin(ang)


def apply_axial_rope(x, cos, sin):
    L, dh = cos.shape
    shape = (L,) + (1,) * (x.ndim - 3) + (dh,)
    cs = cos.reshape(shape).astype(x.dtype)
    sn = sin.reshape(shape).astype(x.dtype)
    half, q4 = dh // 2, dh // 4
    xr, xc = x[..., :half], x[..., half:]
    rot = jnp.concatenate([-xr[..., q4:], xr[..., :q4], -xc[..., q4:], xc[..., :q4]], axis=-1)
    return x * cs + rot * sn


def attend(q, k, v, keep, sink):
    s = jnp.einsum('bqhgd,bshd->bhgqs', q, k, preferred_element_type=jnp.float32) * ATTN_SCALE
    if keep is not None:
        s = jnp.where(keep, s, NEG_INF)
    if sink is not None:
        sk = jnp.broadcast_to(sink.astype(jnp.float32).reshape(1, q.shape[2], q.shape[3], 1, 1),
                              s.shape[:-1] + (1,))
        p = jax.nn.softmax(jnp.concatenate([s, sk], axis=-1), axis=-1)[..., :-1]
    else:
        p = jax.nn.softmax(s, axis=-1)
    return jnp.einsum('bhgqs,bshd->bqhgd', p.astype(v.dtype), v)


def global_attention_latent(q, k_all, v_all):
    B, L, Hk, G, Dh = q.shape
    nb = L // Q_BLOCK
    qb = q.reshape(B, nb, Q_BLOCK, Hk, G, Dh).swapaxes(0, 1)
    out = lax.map(lambda qi: attend(qi, k_all, v_all, None, None), qb)
    return out.swapaxes(0, 1).reshape(B, L, Hk, G, Dh)


def window_attention_latent(q, k, v, k_ctx, v_ctx, sink):
    B, L, Hk, G, Dh = q.shape
    nb = L // Q_BLOCK
    span = 3 * Q_BLOCK
    pad = ((0, 0), (Q_BLOCK, Q_BLOCK), (0, 0), (0, 0))
    kp = jnp.pad(k, pad)
    vp = jnp.pad(v, pad)
    qb = q.reshape(B, nb, Q_BLOCK, Hk, G, Dh).swapaxes(0, 1)
    ctx_keep = jnp.ones((Q_BLOCK, k_ctx.shape[1]), dtype=bool)

    def block(args):
        qi, i = args
        start = i * Q_BLOCK
        kw = lax.dynamic_slice_in_dim(kp, start, span, axis=1)
        vw = lax.dynamic_slice_in_dim(vp, start, span, axis=1)
        qpos = start + jnp.arange(Q_BLOCK)
        kpos = start - Q_BLOCK + jnp.arange(span)
        band = ((kpos >= 0) & (kpos < L))[None, :] & (jnp.abs(qpos[:, None] - kpos[None, :]) <= WINDOW)
        keep = jnp.concatenate([ctx_keep, band], axis=1)
        return attend(qi, jnp.concatenate([k_ctx, kw], axis=1), jnp.concatenate([v_ctx, vw], axis=1), keep, sink)

    out = lax.map(block, (qb, jnp.arange(nb)))
    return out.swapaxes(0, 1).reshape(B, L, Hk, G, Dh)


def multiscale_pool(u, pool_w, pool_scale):
    B, L, _ = u.shape
    uf = u.astype(jnp.float32)
    cs = jnp.concatenate([jnp.zeros_like(uf[:, :1]), jnp.cumsum(uf, axis=1)], axis=1)
    t = jnp.arange(L)
    means = []
    for cs_g, w in zip(jnp.split(cs, POOL_GROUPS, axis=-1), POOL_WINDOWS):
        lo = jnp.maximum(t - (w - 1) // 2, 0)
        hi = jnp.minimum(t + w // 2 + 1, L)
        means.append((cs_g[:, hi] - cs_g[:, lo]) / (hi - lo).astype(jnp.float32)[None, :, None])
    d = (jnp.concatenate(means, axis=-1).astype(u.dtype) - u).reshape(B, L, POOL_GROUPS, POOL_GROUP_W)
    y = jnp.einsum('blgc,gcd->blgd', d, pool_w).reshape(B, L, MIX_W)
    return y * pool_scale


def merge_branches(pool_y, glob_o, win_o, gate_logits, w_branch, w_out):
    B, L, _ = pool_y.shape
    ys = jnp.stack([pool_y, glob_o.reshape(B, L, MIX_W), win_o.reshape(B, L, MIX_W)], axis=2)
    yb = jnp.einsum('blnc,ncd->blnd', ys, w_branch)
    g = jax.nn.sigmoid(gate_logits.reshape(B, L, N_BRANCH, D_MODEL))
    return jnp.einsum('bld,de->ble', jnp.sum(g * yb, axis=2), w_out)


def route(h, router_w, router_b):
    n = h.shape[0]
    scores = jax.nn.sigmoid(jnp.einsum('nd,de->ne', h, router_w, preferred_element_type=jnp.float32))
    sel = (scores + router_b.astype(jnp.float32)).reshape(n, N_GROUPS, EXPERTS_PER_GROUP)
    group_score = jnp.sum(lax.top_k(sel, TOP_K)[0], axis=-1)
    grp = jnp.argmax(group_score, axis=-1)
    in_group = sel[jnp.arange(n), grp]
    _, local = lax.top_k(in_group, TOP_K)
    idx = grp[:, None] * EXPERTS_PER_GROUP + local
    w = jnp.take_along_axis(scores, idx, axis=1)
    return idx, w / jnp.sum(w, axis=-1, keepdims=True)


def moe_ffn(h, router_w, router_b, w_gate, w_up, w_down):
    n, d = h.shape
    idx, w = route(h, router_w, router_b)
    m = n * TOP_K
    flat_e = idx.reshape(m)
    order = jnp.argsort(flat_e)
    sorted_e = flat_e[order]
    counts = jnp.bincount(flat_e, length=N_EXPERTS)
    padded = (counts + MOE_BLOCK - 1) // MOE_BLOCK * MOE_BLOCK
    start = jnp.cumsum(counts) - counts
    pad_end = jnp.cumsum(padded)
    pad_start = pad_end - padded
    dest = pad_start[sorted_e] + jnp.arange(m) - start[sorted_e]
    nblk = -(-m // MOE_BLOCK) + N_EXPERTS
    token = order // TOP_K
    rows = jnp.full((nblk * MOE_BLOCK,), n, dtype=token.dtype).at[dest].set(token)
    blk_e = jnp.minimum(jnp.searchsorted(pad_end, jnp.arange(nblk) * MOE_BLOCK, side='right'), N_EXPERTS - 1)
    h_pad = jnp.concatenate([h, jnp.zeros((1, d), h.dtype)], axis=0)
    xb = h_pad[rows].reshape(nblk, MOE_BLOCK, d)

    def expert_block(args):
        xi, e = args
        return (jax.nn.silu(xi @ w_gate[e]) * (xi @ w_up[e])) @ w_down[e]

    yb = lax.map(expert_block, (xb, blk_e)).reshape(nblk * MOE_BLOCK, d)
    y = yb[dest] * w.reshape(m)[order][:, None].astype(h.dtype)
    return jax.ops.segment_sum(y, token, num_segments=n)


def setup_inputs(seed: int = 0) -> dict:
    key = jax.random.key(seed)
    ks = jax.random.split(key, 24)
    D = D_MODEL

    def nrm(k, shape, scale):
        return jax.random.normal(k, shape, jnp.float32) * scale

    return {
        'x': nrm(ks[0], (BATCH, SEQ, D), 1.0),
        'c': nrm(ks[1], (BATCH, D), 1.0),
        'ctx': nrm(ks[2], (BATCH, CTX_LEN, D), 1.0),
        'c_ctx': nrm(ks[3], (D,), 1.0),
        'w_ada': nrm(ks[4], (DEPTH, D, 6 * D), 0.5 * D ** -0.5),
        'b_ada': nrm(ks[5], (DEPTH, 6 * D), 0.01),
        'norm1_g': 1.0 + nrm(ks[6], (DEPTH, D), 0.02),
        'norm2_g': 1.0 + nrm(ks[7], (DEPTH, D), 0.02),
        'w_in': nrm(ks[8], (DEPTH, D, IN_WIDTH), D ** -0.5),
        'pool_w': nrm(ks[9], (DEPTH, POOL_GROUPS, POOL_GROUP_W, POOL_GROUP_W), POOL_GROUP_W ** -0.5),
        'pool_scale': 1.0 + nrm(ks[10], (DEPTH, MIX_W), 0.1),
        'q_norm_g': 1.0 + nrm(ks[11], (DEPTH, HEAD_DIM), 0.02),
        'k_norm_g': 1.0 + nrm(ks[12], (DEPTH, HEAD_DIM), 0.02),
        'sink': nrm(ks[13], (DEPTH, W_Q_HEADS), 0.5),
        'w_branch': nrm(ks[14], (DEPTH, N_BRANCH, MIX_W, D), MIX_W ** -0.5),
        'w_out': nrm(ks[15], (DEPTH, D, D), D ** -0.5),
        'router_w': nrm(ks[16], (D, N_EXPERTS), D ** -0.5),
        'router_b': nrm(ks[17], (N_EXPERTS,), 0.01),
        'w_gate': nrm(ks[18], (DEPTH, N_EXPERTS, D, EXPERT_FF), D ** -0.5),
        'w_up': nrm(ks[19], (DEPTH, N_EXPERTS, D, EXPERT_FF), D ** -0.5),
        'w_down': nrm(ks[20], (DEPTH, N_EXPERTS, EXPERT_FF, D), EXPERT_FF ** -0.5),
        'final_g': 1.0 + nrm(ks[21], (D,), 0.02),
    }


def reference(x, c, ctx, c_ctx, w_ada, b_ada, norm1_g, norm2_g, w_in, pool_w, pool_scale,
              q_norm_g, k_norm_g, sink, w_branch, w_out, router_w, router_b, w_gate, w_up,
              w_down, final_g):
    B, L, D = x.shape
    C = ctx.shape[1]
    rows = L // GRID_W
    cos, sin = axial_rope_tables(rows)
    silu_c = jax.nn.silu(c)
    silu_cc = jax.nn.silu(c_ctx)
    for l in range(DEPTH):
        last = l == DEPTH - 1
        wl = w_in[l]
        mx = jnp.split(silu_c @ w_ada[l] + b_ada[l], 6, axis=-1)
        mc = jnp.split(jnp.broadcast_to(silu_cc @ w_ada[l] + b_ada[l], (B, 6 * D)), 6, axis=-1)
        sink_l = sink[l].reshape(W_KV_HEADS, W_Q_HEADS // W_KV_HEADS)

        hx = modulate(rmsnorm(x, norm1_g[l]), mx[0], mx[1])
        hc = modulate(rmsnorm(ctx, norm1_g[l]), mc[0], mc[1])
        p = jnp.einsum('bld,de->ble', hx, wl)
        ux = p[..., :OFF_GQ]
        gqx = apply_axial_rope(rmsnorm(as_q(p[..., OFF_GQ:OFF_GK], G_KV_HEADS), q_norm_g[l]), cos, sin)
        gkx = apply_axial_rope(rmsnorm(as_kv(p[..., OFF_GK:OFF_GV]), k_norm_g[l]), cos, sin)
        gvx = as_kv(p[..., OFF_GV:OFF_WQ])
        wqx = apply_axial_rope(as_q(p[..., OFF_WQ:OFF_WK], W_KV_HEADS), cos, sin)
        wkx = apply_axial_rope(as_kv(p[..., OFF_WK:OFF_WV]), cos, sin)
        wvx = as_kv(p[..., OFF_WV:OFF_GATE])
        glx = p[..., OFF_GATE:]
        gkc = rmsnorm(as_kv(proj_cols(hc, wl, OFF_GK, OFF_GV)), k_norm_g[l])
        gvc = as_kv(proj_cols(hc, wl, OFF_GV, OFF_WQ))
        wkc = as_kv(proj_cols(hc, wl, OFF_WK, OFF_WV))
        wvc = as_kv(proj_cols(hc, wl, OFF_WV, OFF_GATE))

        glob_x = global_attention_latent(gqx, jnp.concatenate([gkc, gkx], axis=1), jnp.concatenate([gvc, gvx], axis=1))
        win_x = window_attention_latent(wqx, wkx, wvx, wkc, wvc, sink_l)
        pool_x = multiscale_pool(ux, pool_w[l], pool_scale[l])
        x = x + mx[2][:, None, :] * merge_branches(pool_x, glob_x, win_x, glx, w_branch[l], w_out[l])

        if not last:
            uc = proj_cols(hc, wl, 0, OFF_GQ)
            gqc = rmsnorm(as_q(proj_cols(hc, wl, OFF_GQ, OFF_GK), G_KV_HEADS), q_norm_g[l])
            wqc = as_q(proj_cols(hc, wl, OFF_WQ, OFF_WK), W_KV_HEADS)
            glc = proj_cols(hc, wl, OFF_GATE, IN_WIDTH)
            glob_c = attend(gqc, gkc, gvc, None, None)
            win_c = attend(wqc, wkc, wvc, None, sink_l)
            pool_c = multiscale_pool(uc, pool_w[l], pool_scale[l])
            ctx = ctx + mc[2][:, None, :] * merge_branches(pool_c, glob_c, win_c, glc, w_branch[l], w_out[l])

        hx2 = modulate(rmsnorm(x, norm2_g[l]), mx[3], mx[4]).reshape(B * L, D)
        if last:
            yx = moe_ffn(hx2, router_w, router_b, w_gate[l], w_up[l], w_down[l])
        else:
            hc2 = modulate(rmsnorm(ctx, norm2_g[l]), mc[3], mc[4]).reshape(B * C, D)
            y = moe_ffn(jnp.concatenate([hc2, hx2], axis=0), router_w, router_b, w_gate[l], w_up[l], w_down[l])
            ctx = ctx + mc[5][:, None, :] * y[:B * C].reshape(B, C, D)
            yx = y[B * C:]
        x = x + mx[5][:, None, :] * yx.reshape(B, L, D)

    return rmsnorm(x, final_g)
```

```cpp
#include <hip/hip_runtime.h>
#include <cstdio>
#include <cstdint>

#ifndef PROBE_ATTN
#define PROBE_ATTN 0
#endif
#ifndef MK_PER_PHASE
#define MK_PER_PHASE 0
#endif

constexpr int DM = 2048, SEQ = 8192, CTX = 256, TOK = SEQ + CTX, DEPTH = 2;
constexpr int HD = 128, MIXW = 1024, INW = 10240, NEXP = 32, FFD = 1024;
constexpr int OFF_GQ = 1024, OFF_GK = 2048, OFF_GV = 2304, OFF_WQ = 2560, OFF_WK = 3584, OFF_WV = 3840, OFF_GATE = 4096;
constexpr int ADA = 6 * DM;
constexpr float RMS_EPS = 1e-6f;
constexpr int XS_ROWS = 25088;

constexpr size_t MiB = 1u << 20;
constexpr size_t WS_CTL = 0, CTL_ZERO_BYTES = 2 * MiB;
constexpr size_t WS_MOD = 2 * MiB;
constexpr size_t WS_WIN = 4 * MiB;
constexpr size_t WS_WBR = 84 * MiB;
constexpr size_t WS_WOUT = 108 * MiB;
constexpr size_t WS_POOL = 124 * MiB;
constexpr size_t WS_WGU = 126 * MiB;
constexpr size_t WS_WD = 638 * MiB;
constexpr size_t WS_XA = 894 * MiB;
constexpr size_t WS_XB = 960 * MiB;
constexpr size_t WS_H = 1026 * MiB;
constexpr size_t WS_P = 1059 * MiB;
constexpr size_t WS_DP = 1224 * MiB;
constexpr size_t WS_QG = 1241 * MiB;
constexpr size_t WS_QW = 1258 * MiB;
constexpr size_t WS_KG = 1275 * MiB;
constexpr size_t WS_VG = 1280 * MiB;
constexpr size_t WS_KW = 1285 * MiB;
constexpr size_t WS_VW = 1290 * MiB;
constexpr size_t WS_YB = 1295 * MiB;
constexpr size_t WS_MG8 = 1345 * MiB;
constexpr size_t WS_MG = 1411 * MiB;
constexpr size_t WS_H2 = 1444 * MiB;
constexpr size_t WS_XS = 1477 * MiB;
constexpr size_t WS_ACT = 1575 * MiB;
constexpr size_t WS_Y2 = 1624 * MiB;
constexpr size_t WS_ROUTE = 1722 * MiB;
constexpr size_t WS_ROPE = 1724 * MiB;
constexpr size_t WS_Q8G = 1728 * MiB;
constexpr size_t WS_Q8W = 1737 * MiB;
constexpr size_t WS_K8G = 1746 * MiB;
constexpr size_t WS_K8W = 1749 * MiB;
constexpr size_t WS_VTG = 1752 * MiB;
constexpr size_t WS_VTW = 1755 * MiB;
constexpr size_t WS_H8 = 1758 * MiB;
constexpr size_t WS_END = 1776 * MiB;
constexpr size_t YB_STRIDE = (size_t)TOK * MIXW;

constexpr float ACT_SCALE = 8.0f;
constexpr float W8_SCALE = 32.0f;
constexpr int E8M0_ONE = 0x7F7F7F7F, E8M0_ACT = 0x7C7C7C7C  , E8M0_W = 0x7A7A7A7A  , E8M0_MG = 0x7B7B7B7B  ;
constexpr float MG_SCALE = 16.0f;
constexpr int CW_BAR = 4096;
constexpr int CW_DONE = 197632;
constexpr int CW_QHEAD = 196608;
constexpr int CW_PRB = 200000;
constexpr int CW_CNT = 131072;

constexpr int RING_BYTES = 131072, AUX_OFF = RING_BYTES, AUX_BYTES = 8192, MISC_OFF = AUX_OFF + AUX_BYTES;
constexpr int LDS_BYTES = 147456;
constexpr int NWAVES = 8, NTHR = 512;

#define GAS __attribute__((address_space(1)))
#define LAS __attribute__((address_space(3)))
typedef unsigned short bf16_t;
typedef unsigned u32x4 __attribute__((ext_vector_type(4)));
typedef unsigned u32x2 __attribute__((ext_vector_type(2)));
typedef float f32x4 __attribute__((ext_vector_type(4)));
typedef float f32x2 __attribute__((ext_vector_type(2)));
typedef short bf16x8 __attribute__((ext_vector_type(8)));
typedef short s16x4 __attribute__((ext_vector_type(4)));
typedef float f32x16 __attribute__((ext_vector_type(16)));

__device__ __forceinline__ unsigned cvt_pk_bf16(float lo, float hi) { unsigned r; asm volatile("v_cvt_pk_bf16_f32 %0, %1, %2" : "=v"(r) : "v"(lo), "v"(hi)); return r; }
__device__ __forceinline__ float bf2f(unsigned short b) { return __uint_as_float(((unsigned)b) << 16); }
__device__ __forceinline__ float bflo(unsigned w) { return __uint_as_float(w << 16); }
__device__ __forceinline__ float bfhi(unsigned w) { return __uint_as_float(w & 0xffff0000u); }
__device__ __forceinline__ unsigned short f2bf(float f) { return (unsigned short)(cvt_pk_bf16(f, 0.f) & 0xffffu); }
typedef int i32x4 __attribute__((ext_vector_type(4)));
typedef int i32x8 __attribute__((ext_vector_type(8)));
__device__ __forceinline__ float clamp448(float x) { return __builtin_amdgcn_fmed3f(x, -448.f, 448.f); }
__device__ __forceinline__ unsigned pk_fp8x4(const f32x4 v) {
    int w = 0;
    w = __builtin_amdgcn_cvt_pk_fp8_f32(clamp448(v.x), clamp448(v.y), w, false);
    w = __builtin_amdgcn_cvt_pk_fp8_f32(clamp448(v.z), clamp448(v.w), w, true);
    return (unsigned)w;
}
__device__ __forceinline__ unsigned pk_fp8x4_nc(float a, float b, float c, float d) {
    int w = 0; w = __builtin_amdgcn_cvt_pk_fp8_f32(a, b, w, false); w = __builtin_amdgcn_cvt_pk_fp8_f32(c, d, w, true); return (unsigned)w; }
__device__ __forceinline__ int lane4_fresh() { int l; asm volatile("v_mbcnt_lo_u32_b32 %0, -1, 0\n\tv_mbcnt_hi_u32_b32 %0, -1, %0\n\tv_lshlrev_b32 %0, 2, %0" : "=v"(l)); return l; }
__device__ __forceinline__ float shx(float v, int o, int l4) { return __int_as_float(__builtin_amdgcn_ds_bpermute(l4 ^ (o << 2), __float_as_int(v))); }
__device__ __forceinline__ float wave_sum(float v) {
    const int l4 = lane4_fresh();
#pragma unroll
    for (int o = 1; o < 64; o <<= 1) v += shx(v, o, l4);
    return v;
}
__device__ __forceinline__ int ltid() { int t = threadIdx.x; asm volatile("" : "+v"(t)); return t; }
__device__ __forceinline__ float sigmoidf_(float x) { return __builtin_amdgcn_rcpf(1.0f + __builtin_amdgcn_exp2f(-1.4426950408889634f * x)); }

#define XB_TMO      128
#define XB_XCNT(j)  (256  + 64 * (j))
#define XB_XSUB(j)  (1280 + 64 * (j))
#define XB_XGEN(j)  (2304 + 64 * (j))
#define XB_TOP      3328
#define XB_TOPGEN   3392
#define XCD_BAR_WORDS 3456
#define XB_SPIN_CAP (1u << 18)

__device__ __forceinline__ unsigned xb_ld(unsigned* p)              { return __hip_atomic_load(p, __ATOMIC_RELAXED, __HIP_MEMORY_SCOPE_AGENT); }
__device__ __forceinline__ unsigned xb_add(unsigned* p, unsigned v) { return __hip_atomic_fetch_add(p, v, __ATOMIC_RELAXED, __HIP_MEMORY_SCOPE_AGENT); }
__device__ __forceinline__ unsigned xb_xcc_id() { return (unsigned)__builtin_amdgcn_s_getreg((3 << 11) | 20) & 0xFu; }
#define XB_SPIN(cond, bar) do { unsigned _sp = 0; while (cond) { __builtin_amdgcn_s_sleep(1); \
    if ((++_sp & 255u) == 0u) { if (xb_ld(&(bar)[XB_TMO])) break; if (_sp > XB_SPIN_CAP) { atomicAdd(&(bar)[XB_TMO], 1u); break; } } } } while (0)

struct XcdBarrier {
    unsigned* bar; unsigned x;
    volatile LAS unsigned* st;
};
__device__ __forceinline__ XcdBarrier xcd_barrier_post(unsigned* bar, volatile LAS unsigned* st) {
    XcdBarrier b; b.bar = bar; b.x = xb_xcc_id(); b.st = st;
    if (threadIdx.x == 0) (void)xb_add(&bar[XB_XCNT(b.x)], 1u);
    return b;
}
__device__ __forceinline__ void xcd_barrier_complete(unsigned* bar, unsigned x, unsigned& nloc, unsigned& nx) {
    const unsigned G = gridDim.x * gridDim.y * gridDim.z;
    unsigned sum, cnt, mine, sp = 0u;
    for (;;) {
        sum = 0u; cnt = 0u; mine = 0u;
#pragma unroll
        for (unsigned j = 0; j < 16; ++j) { const unsigned c = xb_ld(&bar[XB_XCNT(j)]); sum += c; cnt += (c > 0u) ? 1u : 0u; mine = (j == x) ? c : mine; }
        if (sum == G) break;
        __builtin_amdgcn_s_sleep(1);
        if ((++sp & 255u) == 0u) { if (xb_ld(&bar[XB_TMO])) break; if (sp > XB_SPIN_CAP) { atomicAdd(&bar[XB_TMO], 1u); break; } }
    }
    nloc = mine > 0u ? mine : 1u; nx = cnt > 0u ? cnt : 1u;
}
__device__ __forceinline__ void xcd_barrier(const XcdBarrier& b) {
    asm volatile("s_waitcnt vmcnt(0)" ::: "memory");
    __syncthreads();
    if (threadIdx.x == 0) {
        unsigned* bar = b.bar;
        __builtin_amdgcn_s_waitcnt(0);
        unsigned nloc = b.st[0], nx = b.st[1];
        if (nloc == 0u) { xcd_barrier_complete(bar, b.x, nloc, nx); b.st[0] = nloc; b.st[1] = nx; }
        const unsigned old = xb_add(&bar[XB_XSUB(b.x)], 1u);
        const unsigned gen = old / nloc;
        if (old + 1u == (gen + 1u) * nloc) {
            __builtin_amdgcn_fence(__ATOMIC_RELEASE, "agent");
            asm volatile("s_waitcnt vmcnt(0)" ::: "memory");
            const unsigned og = xb_add(&bar[XB_TOP], 1u);
            const unsigned tg = og / nx;
            if (og + 1u == (tg + 1u) * nx) xb_add(&bar[XB_TOPGEN], 1u);
            else XB_SPIN(xb_ld(&bar[XB_TOPGEN]) == tg, bar);
            __builtin_amdgcn_fence(__ATOMIC_ACQUIRE, "agent");
            xb_add(&bar[XB_XGEN(b.x)], 1u);
            asm volatile("s_waitcnt vmcnt(0)" ::: "memory");
        } else {
            XB_SPIN(xb_ld(&bar[XB_XGEN(b.x)]) == gen, bar);
            __builtin_amdgcn_fence(__ATOMIC_ACQUIRE, "agent");
            asm volatile("s_waitcnt vmcnt(0)" ::: "memory");
        }
    }
    __syncthreads();
}

namespace pg8 {
constexpr int BM = 256, BK = 64, HALF = 128, HTB = HALF * BK * 2, STAGE_BYTES = 8 * HTB;
__device__ __forceinline__ int lds_byte(int r, int c) { const int st = (r >> 4) * 2 + (c >> 5), rr = r & 15, cc = c & 31, ob = rr * 64 + cc * 2; return st * 1024 + (ob ^ (((ob >> 9) & 1) << 5)); }
__device__ __forceinline__ void stage_rc(int b, int& R, int& C) { const int st = b / 1024, sb = b % 1024, swz = sb ^ (((sb >> 9) & 1) << 5); R = (st >> 1) * 16 + swz / 64; C = (st & 1) * 32 + (swz % 64) / 2; }
__device__ __forceinline__ int perm32(int rho) { const int n = rho >> 4, i = rho & 15; return 8 * (i >> 2) + 4 * n + (i & 3); }

struct Unit { int pm, pn, e, half; const char* a; const char* b; };
struct Gemm { int lda, ldb, K; int sw, sa; int kb; };

template <class Epi, class Sched, bool GATHER = false, bool F8 = false>
__device__ __forceinline__ void gemm_phase(LAS unsigned char* lds, const Gemm g, const Sched& S, const Epi& E) {
    int tid = threadIdx.x; asm volatile("" : "+v"(tid));
    const int wid = __builtin_amdgcn_readfirstlane(tid >> 6), lane = tid & 63, wr = wid >> 2, wc = wid & 3, fr = lane & 15, fq = lane >> 4;
    constexpr int ESZ = F8 ? 1 : 2;
    const int nt = g.K / (F8 ? 128 : BK);
    unsigned voffA[2], voffB[2]; int rowA[2];
#pragma unroll
    for (int i = 0; i < 2; ++i) { int R, C; stage_rc(tid * 16 + i * 8192, R, C); const int Rb = Epi::PERM ? ((R & ~31) + perm32(R & 31)) : R;
        voffA[i] = GATHER ? (unsigned)C * 2u : (unsigned)(R * g.lda * ESZ + C * 2); voffB[i] = (unsigned)(Rb * g.ldb * ESZ + C * 2); rowA[i] = R; }
    unsigned cv0[2] = {0u, 0u}, cv1[2] = {0u, 0u}, nv0[2] = {0u, 0u}, nv1[2] = {0u, 0u};
#define PG8_GOFF(u_, v0_, v1_) do { if constexpr (GATHER) { _Pragma("unroll") for (int _i = 0; _i < 2; ++_i) { \
        v0_[_i] = (unsigned)S.a_row(u_, rowA[_i]) * (unsigned)(g.lda * ESZ) + voffA[_i]; v1_[_i] = (unsigned)S.a_row(u_, rowA[_i] + HALF) * (unsigned)(g.lda * ESZ) + voffA[_i]; } } } while (0)
#define PG8_STAGE_A(bufoff, gbase, h, nx) do { if constexpr (GATHER) { unsigned va_[2]; va_[0] = (nx) ? ((h) ? nv1[0] : nv0[0]) : ((h) ? cv1[0] : cv0[0]); va_[1] = (nx) ? ((h) ? nv1[1] : nv0[1]) : ((h) ? cv1[1] : cv0[1]); \
        PG8_STAGE(bufoff, gbase, va_); } else { PG8_STAGE(bufoff, (gbase) + ((h) ? hstepA : (size_t)0), voffA); } } while (0)
    const size_t kstep = (size_t)(BK * 2), kstepB = g.kb ? (size_t)g.kb : kstep;
    const size_t hstepA = (size_t)HALF * g.lda * ESZ, hstepB = (size_t)HALF * g.ldb * ESZ;
    const unsigned ldsw = (unsigned)wid * 1024u;
    const int aoff = F8 ? lds_byte(wr * 64 + fr, fq * 16) + (fq & 1) * 16 : lds_byte(wr * 64 + fr, fq * 8), boff = F8 ? lds_byte(wc * 32 + fr, fq * 16) + (fq & 1) * 16 : lds_byte(wc * 32 + fr, fq * 8);
    const int aoff2 = aoff ^ 16, boff2 = boff ^ 16;
#define PG8_SA(b, h) (((b) * 2 + (h)) * HTB)
#define PG8_SB(b, h) ((4 + (b) * 2 + (h)) * HTB)
#define PG8_STAGE(bufoff, gbase, voff) do { _Pragma("unroll") for (int _i = 0; _i < 2; ++_i) \
        __builtin_amdgcn_global_load_lds((const unsigned*)((const char*)(gbase) + (voff)[_i]), (LAS unsigned*)(lds + (bufoff) + ldsw + _i * 8192), 16, 0, 0); } while (0)
#define PG8_LDA(dst, b, h) do { if constexpr (F8) { _Pragma("unroll") for (int m = 0; m < 4; ++m) dst##8[m] = PG8_CAT(*(const LAS i32x4*)(lds + PG8_SA(b, h) + aoff + m * 2048), *(const LAS i32x4*)(lds + PG8_SA(b, h) + aoff2 + m * 2048)); } else { \
        _Pragma("unroll") for (int m = 0; m < 4; ++m) _Pragma("unroll") for (int k = 0; k < 2; ++k) dst[m][k] = *(const LAS bf16x8*)(lds + PG8_SA(b, h) + aoff + m * 2048 + k * 1024); } } while (0)
#define PG8_LDB(dst, b, h) do { if constexpr (F8) { _Pragma("unroll") for (int n = 0; n < 2; ++n) dst##8[n] = PG8_CAT(*(const LAS i32x4*)(lds + PG8_SB(b, h) + boff + n * 2048), *(const LAS i32x4*)(lds + PG8_SB(b, h) + boff2 + n * 2048)); } else { \
        _Pragma("unroll") for (int n = 0; n < 2; ++n) _Pragma("unroll") for (int k = 0; k < 2; ++k) dst[n][k] = *(const LAS bf16x8*)(lds + PG8_SB(b, h) + boff + n * 2048 + k * 1024); } } while (0)
#define PG8_CAT(x0, x1) __builtin_shufflevector(__builtin_bit_cast(i32x4, x0), __builtin_bit_cast(i32x4, x1), 0, 1, 2, 3, 4, 5, 6, 7)
#define PG8_MMA(ai, bj, At, Bt) do { __builtin_amdgcn_s_setprio(1); if constexpr (F8) { _Pragma("unroll") for (int m = 0; m < 4; ++m) _Pragma("unroll") for (int n = 0; n < 2; ++n) \
        asm volatile("v_mfma_f32_16x16x128_f8f6f4 %0, %1, %2, %0" : "+v"(acc[ai][bj][m][n]) : "v"(Bt##8[n]), "v"(At##8[m])); } else { \
        _Pragma("unroll") for (int m = 0; m < 4; ++m) _Pragma("unroll") for (int n = 0; n < 2; ++n) _Pragma("unroll") for (int k = 0; k < 2; ++k) \
        acc[ai][bj][m][n] = __builtin_amdgcn_mfma_f32_16x16x32_bf16(Bt[n][k], At[m][k], acc[ai][bj][m][n], 0, 0, 0); } __builtin_amdgcn_s_setprio(0); } while (0)
#define PG8_WAIT_V(n) asm volatile("s_waitcnt vmcnt(" #n ")" ::: "memory")
#define PG8_WAIT_L(n) asm volatile("s_waitcnt lgkmcnt(" #n ")" ::: "memory")
#define PG8_BAR __builtin_amdgcn_s_barrier()
#define PG8_SCHED __builtin_amdgcn_sched_barrier(0)
    Unit cur, nxt; int ui = 0;
    if (!S.next(0, cur)) return;
    f32x4 acc[2][2][4][2];
#pragma unroll
    for (int a = 0; a < 2; ++a)
#pragma unroll
        for (int b = 0; b < 2; ++b)
#pragma unroll
            for (int m = 0; m < 4; ++m)
#pragma unroll
                for (int n = 0; n < 2; ++n) acc[a][b][m][n] = (f32x4){0.f, 0.f, 0.f, 0.f};
    bf16x8 At[4][2], B0[2][2], B1[2][2]; i32x8 At8[4], B08[2], B18[2];
    const float fs_ = F8 ? __uint_as_float((unsigned)((g.sw & 255) + (g.sa & 255) - 127) << 23) : 1.0f;
    const char* cA = cur.a; const char* cB = cur.b;
    PG8_GOFF(cur, cv0, cv1);
    PG8_STAGE(PG8_SB(0, 0), cB, voffB); PG8_STAGE_A(PG8_SA(0, 0), cA, 0, false); PG8_STAGE(PG8_SB(0, 1), cB + hstepB, voffB); PG8_STAGE_A(PG8_SA(0, 1), cA, 1, false);
    if (wr == 1) PG8_BAR;
    PG8_WAIT_V(4); PG8_BAR;
    PG8_STAGE(PG8_SB(1, 0), cB + kstepB, voffB); PG8_STAGE_A(PG8_SA(1, 0), cA + kstep, 0, false); PG8_STAGE(PG8_SB(1, 1), cB + hstepB + kstepB, voffB);
    PG8_WAIT_V(6); PG8_BAR;
    for (;;) {
        const bool has_next = S.next(ui + 1, nxt);
        const bool chalf = __builtin_amdgcn_readfirstlane(cur.half) != 0;
        const char* nA = has_next ? nxt.a : cA; const char* nB = has_next ? nxt.b : cB;
        if constexpr (GATHER) { if (has_next) PG8_GOFF(nxt, nv0, nv1); else { nv0[0] = cv0[0]; nv0[1] = cv0[1]; nv1[0] = cv1[0]; nv1[1] = cv1[1]; } }
#pragma nounroll
        for (int t = 0; t < nt; t += 2) {
            const bool last = (t == nt - 2);
            const char* a1 = cA + (size_t)(t + 1) * kstep;
            const char* a2 = last ? nA : cA + (size_t)(t + 2) * kstep; const char* b2 = last ? nB : cB + (size_t)(t + 2) * kstepB;
            const char* a3 = a2 + kstep; const char* b3 = b2 + kstepB;
            PG8_LDB(B0, 0, 0); PG8_SCHED; PG8_LDA(At, 0, 0); PG8_STAGE_A(PG8_SA(1, 1), a1, 1, false);
            PG8_WAIT_L(8); PG8_BAR; PG8_WAIT_L(0); PG8_MMA(0, 0, At, B0); PG8_BAR; PG8_SCHED;
            PG8_LDB(B1, 0, 1); PG8_STAGE(PG8_SB(0, 0), b2, voffB);
            PG8_BAR; PG8_WAIT_L(0); PG8_MMA(0, 1, At, B1); PG8_BAR;
            PG8_LDA(At, 0, 1); PG8_STAGE_A(PG8_SA(0, 0), a2, 0, last);
            PG8_BAR; PG8_WAIT_L(0); if (!chalf) PG8_MMA(1, 0, At, B0); PG8_BAR; PG8_SCHED;
            PG8_STAGE(PG8_SB(0, 1), b2 + hstepB, voffB);
            PG8_WAIT_V(6); PG8_BAR; if (!chalf) PG8_MMA(1, 1, At, B1); PG8_BAR;
            PG8_LDB(B0, 1, 0); PG8_SCHED; PG8_LDA(At, 1, 0); PG8_STAGE_A(PG8_SA(0, 1), a2, 1, last);
            PG8_WAIT_L(8); PG8_BAR; PG8_WAIT_L(0); PG8_MMA(0, 0, At, B0); PG8_BAR; PG8_SCHED;
            PG8_LDB(B1, 1, 1); PG8_STAGE(PG8_SB(1, 0), b3, voffB);
            PG8_BAR; PG8_WAIT_L(0); PG8_MMA(0, 1, At, B1); PG8_BAR;
            PG8_LDA(At, 1, 1); PG8_STAGE_A(PG8_SA(1, 0), a3, 0, last);
            PG8_BAR; PG8_WAIT_L(0); if (!chalf) PG8_MMA(1, 0, At, B0); PG8_BAR; PG8_SCHED;
            PG8_STAGE(PG8_SB(1, 1), b3 + hstepB, voffB);
            PG8_WAIT_V(6); PG8_BAR; if (!chalf) PG8_MMA(1, 1, At, B1); PG8_BAR;
        }
        if constexpr (F8) asm volatile("s_nop 15\n\ts_nop 15" ::: "memory");
        { float fsl_ = fs_; asm volatile("" : "+s"(fsl_));
          E(acc, cur, wr, wc, fr, fq, fsl_); }
        if (!has_next) break;
#pragma unroll
        for (int a = 0; a < 2; ++a)
#pragma unroll
            for (int b = 0; b < 2; ++b)
#pragma unroll
                for (int m = 0; m < 4; ++m)
#pragma unroll
                    for (int n = 0; n < 2; ++n) acc[a][b][m][n] = (f32x4){0.f, 0.f, 0.f, 0.f};
        if constexpr (F8) { _Pragma("unroll") for (int a = 0; a < 2; ++a) _Pragma("unroll") for (int b = 0; b < 2; ++b) _Pragma("unroll") for (int m = 0; m < 4; ++m) _Pragma("unroll") for (int n = 0; n < 2; ++n) asm volatile("" : "+v"(acc[a][b][m][n])); asm volatile("s_nop 7" ::: "memory"); }
        cur = nxt; cA = nA; cB = nB; ++ui;
        if constexpr (GATHER) { cv0[0] = nv0[0]; cv0[1] = nv0[1]; cv1[0] = nv1[0]; cv1[1] = nv1[1]; }
    }
    PG8_WAIT_V(0);
    if (wr == 0) PG8_BAR;
    PG8_BAR;
#undef PG8_SA
#undef PG8_SB
#undef PG8_STAGE
#undef PG8_STAGE_A
#undef PG8_GOFF
#undef PG8_LDA
#undef PG8_LDB
#undef PG8_MMA
#undef PG8_CAT
#undef PG8_WAIT_V
#undef PG8_WAIT_L
#undef PG8_BAR
#undef PG8_SCHED
}
}

#ifndef ATT_FIXED
#define ATT_FIXED 1
#endif
namespace att {
constexpr int QBLK = 32, KVBLK = 64;
constexpr float SCALE = 0.088388347648318440f;
constexpr float THR = 8.f;
constexpr int SHM_V = KVBLK * HD * 2, SHM_K = KVBLK * HD * 2, SHM_ATTN = 2 * SHM_V + 2 * SHM_K + NWAVES * 64 * 4;
#define KSWZ(row, colB) ((row) * 256 + ((colB) ^ (((row) & 7) << 4)))
#define SBAR() __builtin_amdgcn_sched_barrier(0)
__device__ __forceinline__ int crow(int r, int hi) { return (r & 3) + 8 * (r >> 2) + 4 * hi; }
__device__ __forceinline__ unsigned cvtpk(float lo, float hi) { unsigned r; asm volatile("v_cvt_pk_bf16_f32 %0, %1, %2" : "=v"(r) : "v"(lo), "v"(hi)); return r; }

__device__ __forceinline__ void apply_mask(f32x16& p0, f32x16& p1, int kp0, int qpos, int hi) {
#pragma unroll
    for (int r = 0; r < 16; ++r) {
        const int k0 = kp0 + (r & 3) + 8 * (r >> 2) + 4 * hi, k1 = k0 + 32;
        const bool v0 = ((unsigned)k0 < (unsigned)SEQ) && ((unsigned)(k0 - qpos + 128) <= 256u);
        const bool v1 = ((unsigned)k1 < (unsigned)SEQ) && ((unsigned)(k1 - qpos + 128) <= 256u);
        p0[r] = v0 ? p0[r] : -1e30f; p1[r] = v1 ? p1[r] : -1e30f;
    }
}
__device__ __forceinline__ void partialSM(f32x16& p0, f32x16& p1, float& m_reg, float& mn, float& alpha) {
    constexpr float C = SCALE * 1.4426950408889634f;
    float pmax = p0[0];
#pragma unroll
    for (int r = 1; r < 16; ++r) pmax = fmaxf(pmax, p0[r]);
#pragma unroll
    for (int r = 0; r < 16; ++r) pmax = fmaxf(pmax, p1[r]);
    { auto rr = __builtin_amdgcn_permlane32_swap(__float_as_uint(pmax), __float_as_uint(pmax), false, false);
      pmax = fmaxf(__uint_as_float(rr[0]), __uint_as_float(rr[1])); }
    if (__builtin_expect(__all(pmax - m_reg <= THR / SCALE), 1)) { mn = m_reg; alpha = 1.f; }
    else { mn = fmaxf(m_reg, pmax); alpha = __builtin_amdgcn_exp2f((m_reg - mn) * C); m_reg = mn; }
    float mnC = -mn * C;
#pragma unroll
    for (int r = 0; r < 16; ++r) p0[r] = fmaf(p0[r], C, mnC);
#pragma unroll
    for (int r = 0; r < 16; ++r) p1[r] = fmaf(p1[r], C, mnC);
#pragma unroll
    for (int r = 0; r < 16; ++r) p0[r] = __builtin_amdgcn_exp2f(p0[r]);
}
__device__ __forceinline__ void partialSM_fixed(f32x16& p0, f32x16& p1, float mnC) {
    constexpr float C = SCALE * 1.4426950408889634f;
#pragma unroll
    for (int r = 0; r < 16; ++r) p0[r] = fmaf(p0[r], C, mnC);
#pragma unroll
    for (int r = 0; r < 16; ++r) p1[r] = fmaf(p1[r], C, mnC);
#pragma unroll
    for (int r = 0; r < 16; ++r) p0[r] = __builtin_amdgcn_exp2f(p0[r]);
}
__device__ __forceinline__ void finishSM(f32x16& p0, f32x16& p1, float alpha, float& l_reg, bf16x8& pa0, bf16x8& pa1, bf16x8& pa2, bf16x8& pa3) {
#pragma unroll
    for (int r = 0; r < 16; ++r) p1[r] = __builtin_amdgcn_exp2f(p1[r]);
    float ps = 0;
#pragma unroll
    for (int r = 0; r < 16; ++r) ps += p0[r];
#pragma unroll
    for (int r = 0; r < 16; ++r) ps += p1[r];
    { auto rr = __builtin_amdgcn_permlane32_swap(__float_as_uint(ps), __float_as_uint(ps), false, false);
      ps = __uint_as_float(rr[0]) + __uint_as_float(rr[1]); }
    l_reg = l_reg * alpha + ps;
#define PK4(P, BASE, OUT) do { unsigned a0 = cvtpk(P[BASE + 0], P[BASE + 1]), a1 = cvtpk(P[BASE + 2], P[BASE + 3]);   \
    unsigned b0 = cvtpk(P[BASE + 4], P[BASE + 5]), b1 = cvtpk(P[BASE + 6], P[BASE + 7]);                              \
    auto r0 = __builtin_amdgcn_permlane32_swap(a0, b0, false, false); auto r1 = __builtin_amdgcn_permlane32_swap(a1, b1, false, false); \
    u32x4 w = {r0[0], r1[0], r0[1], r1[1]}; OUT = *reinterpret_cast<bf16x8*>(&w); } while (0)
    PK4(p0, 0, pa0); PK4(p0, 8, pa1); PK4(p1, 0, pa2); PK4(p1, 8, pa3);
#undef PK4
}
__device__ __forceinline__ void qkt(f32x16& p0, f32x16& p1, const bf16_t* Ks, const bf16x8* qr, int r32, int hi) {
    p0 = f32x16{}; p1 = f32x16{};
#pragma unroll
    for (int d0 = 0; d0 < 8; ++d0) { int cb = (d0 * 16 + hi * 8) * 2;
        bf16x8 b0 = *reinterpret_cast<const bf16x8*>((const char*)Ks + KSWZ(r32, cb));
        bf16x8 b1 = *reinterpret_cast<const bf16x8*>((const char*)Ks + KSWZ(32 + r32, cb));
        p0 = __builtin_amdgcn_mfma_f32_32x32x16_bf16(b0, qr[d0], p0, 0, 0, 0);
        p1 = __builtin_amdgcn_mfma_f32_32x32x16_bf16(b1, qr[d0], p1, 0, 0, 0); }
}
__device__ __forceinline__ int v_st(int k, int c) { const int kk = (k & ~0xC) | ((k & 4) << 1) | ((k & 8) >> 1); return ((kk >> 3) * 4 + (c >> 5)) * 512 + ((kk & 7) * 32 + (c & 31)) * 2; }
__device__ __forceinline__ int v_rd_base(int lane) { return ((lane & 3) << 3) | (((lane >> 2) & 3) << 6) | (((lane >> 4) & 1) << 5) | (((lane >> 5) & 1) << 8); }
constexpr int v_rd_off(int d0, int ks, int half) { return d0 * 512 + ks * 4096 + half * 2048; }
template <int OFF> __device__ __forceinline__ s16x4 tr_read(int vb) {
    s16x4 r; asm volatile("ds_read_b64_tr_b16 %0, %1 offset:%2" : "=&v"(r) : "v"(vb), "i"(OFF) : "memory"); return r;
}
template <int D0> __device__ __forceinline__ void pv_one(f32x16& od, int vb, bf16x8 pa0, bf16x8 pa1, bf16x8 pa2, bf16x8 pa3) {
    const s16x4 l0 = tr_read<v_rd_off(D0, 0, 0)>(vb), h0 = tr_read<v_rd_off(D0, 0, 1)>(vb), l1 = tr_read<v_rd_off(D0, 1, 0)>(vb), h1 = tr_read<v_rd_off(D0, 1, 1)>(vb);
    const s16x4 l2 = tr_read<v_rd_off(D0, 2, 0)>(vb), h2 = tr_read<v_rd_off(D0, 2, 1)>(vb), l3 = tr_read<v_rd_off(D0, 3, 0)>(vb), h3 = tr_read<v_rd_off(D0, 3, 1)>(vb);
    asm volatile("s_waitcnt lgkmcnt(0)" ::: "memory"); SBAR();
#define PK(L, H) (bf16x8){L[0], L[1], L[2], L[3], H[0], H[1], H[2], H[3]}
    od = __builtin_amdgcn_mfma_f32_32x32x16_bf16(pa0, PK(l0, h0), od, 0, 0, 0);
    od = __builtin_amdgcn_mfma_f32_32x32x16_bf16(pa1, PK(l1, h1), od, 0, 0, 0);
    od = __builtin_amdgcn_mfma_f32_32x32x16_bf16(pa2, PK(l2, h2), od, 0, 0, 0);
    od = __builtin_amdgcn_mfma_f32_32x32x16_bf16(pa3, PK(l3, h3), od, 0, 0, 0);
#undef PK
}
__device__ __forceinline__ void pv_d0(f32x16* o, int vb, bf16x8 pa0, bf16x8 pa1, bf16x8 pa2, bf16x8 pa3) {
    pv_one<0>(o[0], vb, pa0, pa1, pa2, pa3); pv_one<1>(o[1], vb, pa0, pa1, pa2, pa3); pv_one<2>(o[2], vb, pa0, pa1, pa2, pa3); pv_one<3>(o[3], vb, pa0, pa1, pa2, pa3);
}

template <int MODE>
__device__ __forceinline__ void attn_body(const bf16_t* __restrict__ Qb, const bf16_t* __restrict__ Kh, const bf16_t* __restrict__ Vh,
                                          bf16_t* __restrict__ Ob, int NT, int nctx, int q0, float sink, char* lds) {
    constexpr int ldq = MIXW, ldk = 256, ldo = MIXW;
    int tid = threadIdx.x; asm volatile("" : "+v"(tid));
    const int wid = tid >> 6, lane = tid & 63, r32 = lane & 31, hi = lane >> 5;
    bf16_t* V_lds = (bf16_t*)lds; bf16_t* K_lds = (bf16_t*)(lds + 2 * SHM_V);
    float* ws = (float*)(lds + 2 * SHM_V + 2 * SHM_K) + wid * 64; float* li_l = ws; float* al_l = ws + 32;
    float m_reg = (MODE == 0 && ATT_FIXED) ? sink : -1e30f, l_reg = 0; f32x16 o[4] = {}; bf16x8 qr[8];
    const float mnCf = -m_reg * (SCALE * 1.4426950408889634f);
    const bf16_t* Qw = Qb + (long)(wid * QBLK + r32) * ldq + hi * 8;
#pragma unroll
    for (int d0 = 0; d0 < 8; ++d0) qr[d0] = *reinterpret_cast<const bf16x8*>(Qw + d0 * 16);
    const int sr = tid >> 4, sc = (tid & 15) * 8, vst0 = v_st(sr, sc), vst1 = v_st(32 + sr, sc);
    const int vb0 = (int)(uintptr_t)V_lds + v_rd_base(lane);
    const int qpos = q0 + wid * QBLK + r32;
    const int bandT0 = CTX + q0 - 128;
    struct { bf16x8 vs0, vs1, ks0, ks1; } sr_[2];
#define TROW(jt) ((MODE == 0 || (jt) < nctx) ? (jt) * KVBLK : bandT0 + ((jt) - nctx) * KVBLK)
#define SLOAD(i, jt) do { int ra_ = TROW(jt) + sr, rb_ = ra_ + 32; if (MODE == 1) { ra_ = ra_ < TOK - 1 ? ra_ : TOK - 1; rb_ = rb_ < TOK - 1 ? rb_ : TOK - 1; } \
    sr_[i].vs0 = *reinterpret_cast<const bf16x8*>(&Vh[(long)ra_ * ldk + sc]); sr_[i].vs1 = *reinterpret_cast<const bf16x8*>(&Vh[(long)rb_ * ldk + sc]); \
    sr_[i].ks0 = *reinterpret_cast<const bf16x8*>(&Kh[(long)ra_ * ldk + sc]); sr_[i].ks1 = *reinterpret_cast<const bf16x8*>(&Kh[(long)rb_ * ldk + sc]); } while (0)
#define SWRITE(b, i) do { *(bf16x8*)((char*)V_lds + (b) * SHM_V + vst0) = sr_[i].vs0;          \
    *(bf16x8*)((char*)V_lds + (b) * SHM_V + vst1) = sr_[i].vs1; int kc = sc * 2;               \
    *(bf16x8*)((char*)K_lds + (b) * SHM_K + KSWZ(sr, kc)) = sr_[i].ks0;                       \
    *(bf16x8*)((char*)K_lds + (b) * SHM_K + KSWZ(32 + sr, kc)) = sr_[i].ks1; } while (0)
#define SWAIT() asm volatile("s_waitcnt vmcnt(4)" ::: "memory")
#define RESC(a) do { if (__any((a) < 1.f)) { if (hi == 0) al_l[r32] = (a); asm volatile("s_waitcnt lgkmcnt(0)" ::: "memory"); \
    _Pragma("unroll") for (int d = 0; d < 4; ++d) _Pragma("unroll") for (int r = 0; r < 16; ++r) o[d][r] *= al_l[crow(r, hi)]; } } while (0)
#define MASK(PA, PB, jt) do { if (MODE == 1 && (jt) >= nctx) apply_mask(PA, PB, q0 - 128 + ((jt) - nctx) * KVBLK, qpos, hi); } while (0)
#define PSM(PA, PB, mn_, al_) do { if (MODE == 0 && ATT_FIXED) { partialSM_fixed(PA, PB, mnCf); al_ = 1.f; } else partialSM(PA, PB, m_reg, mn_, al_); } while (0)
#define RESCM(a) do { if (MODE == 1 || !ATT_FIXED) RESC(a); } while (0)
    f32x16 pA0, pA1, pB0, pB1; float mnA, mnB, alA, alB; bf16x8 pa0, pa1, pa2, pa3;
    constexpr int SE = 0, SO = 1;
    SLOAD(SE, 0); asm volatile("s_waitcnt vmcnt(0)" ::: "memory"); SWRITE(0, SE); __syncthreads();
    qkt(pA0, pA1, K_lds, qr, r32, hi); MASK(pA0, pA1, 0); PSM(pA0, pA1, mnA, alA);
    SLOAD(SO, 1); if (2 < NT) SLOAD(SE, 2);
    SWAIT(); SWRITE(1, SO); __syncthreads();
    for (int j = 1; j + 1 < NT; j += 2) {
        SBAR(); qkt(pB0, pB1, (bf16_t*)((char*)K_lds + SHM_K), qr, r32, hi);
        finishSM(pA0, pA1, alA, l_reg, pa0, pa1, pa2, pa3); SBAR();
        SLOAD(SO, j + 2); SBAR();
        pv_d0(o, vb0, pa0, pa1, pa2, pa3); MASK(pB0, pB1, j); PSM(pB0, pB1, mnB, alB);
        __syncthreads(); SWAIT(); SWRITE(0, SE);
        RESCM(alB); __syncthreads();
        SBAR(); qkt(pA0, pA1, K_lds, qr, r32, hi);
        finishSM(pB0, pB1, alB, l_reg, pa0, pa1, pa2, pa3); SBAR();
        if (j + 3 < NT) SLOAD(SE, j + 3); SBAR();
        pv_d0(o, vb0 + (int)SHM_V, pa0, pa1, pa2, pa3); MASK(pA0, pA1, j + 1); PSM(pA0, pA1, mnA, alA);
        __syncthreads(); SWAIT(); SWRITE(1, SO);
        RESCM(alA); __syncthreads();
    }
    SBAR(); qkt(pB0, pB1, (bf16_t*)((char*)K_lds + SHM_K), qr, r32, hi);
    finishSM(pA0, pA1, alA, l_reg, pa0, pa1, pa2, pa3); SBAR();
    pv_d0(o, vb0, pa0, pa1, pa2, pa3); MASK(pB0, pB1, NT - 1); PSM(pB0, pB1, mnB, alB);
    __syncthreads(); RESCM(alB);
    finishSM(pB0, pB1, alB, l_reg, pa0, pa1, pa2, pa3); SBAR();
    pv_d0(o, vb0 + (int)SHM_V, pa0, pa1, pa2, pa3);
    if (MODE == 1) l_reg += __builtin_amdgcn_exp2f(sink * 1.4426950408889634f - m_reg * (SCALE * 1.4426950408889634f));
    if (hi == 0) li_l[r32] = l_reg; asm volatile("s_waitcnt lgkmcnt(0)" ::: "memory");
    float rli[16];
#pragma unroll
    for (int r = 0; r < 16; ++r) rli[r] = __builtin_amdgcn_rcpf(li_l[crow(r, hi)]);
    bf16_t* Ow = Ob + (long)(wid * QBLK) * ldo;
#pragma unroll
    for (int r = 0; r < 16; ++r) { int orow = crow(r, hi);
#pragma unroll
        for (int d0 = 0; d0 < 4; ++d0) Ow[(long)orow * ldo + d0 * 32 + r32] = f2bf(o[d0][r] * rli[r]); }
    asm volatile("s_waitcnt vmcnt(0) lgkmcnt(0)" ::: "memory");
    __syncthreads();
#undef TROW
#undef SLOAD
#undef SWRITE
#undef SWAIT
#undef RESC
#undef MASK
#undef PSM
#undef RESCM
}
}


namespace att8 {
constexpr int KVBLK = 64, QBLK = 32;
constexpr float SCALE = att::SCALE, THR8 = 1.5f, PSCALE = 64.f;
constexpr int E_ONE = 0x7F7F7F7F, E_P = 0x79797979;
constexpr int SHM8_K = 8192, SHM8_V = 8192;
__device__ __forceinline__ void mfma8(f32x16& acc, const i32x8& a, const i32x8& b, int sa, int sb) {
    asm volatile("v_mfma_scale_f32_32x32x64_f8f6f4 %0, %1, %2, %0, %3, %4 op_sel_hi:[0,0,0]" : "+v"(acc) : "v"(a), "v"(b), "v"(sa), "v"(sb)); }
__device__ __forceinline__ void mfma8_pre(f32x16& acc, const i32x8& a, const i32x8& b, int sa, int sb) {
    asm volatile("s_nop 3\n\tv_mfma_scale_f32_32x32x64_f8f6f4 %0, %1, %2, %0, %3, %4 op_sel_hi:[0,0,0]" : "+v"(acc) : "v"(a), "v"(b), "v"(sa), "v"(sb)); }
__device__ __forceinline__ void mfma8_post(f32x16& acc, const i32x8& a, const i32x8& b, int sa, int sb) {
    asm volatile("v_mfma_scale_f32_32x32x64_f8f6f4 %0, %1, %2, %0, %3, %4 op_sel_hi:[0,0,0]\n\ts_nop 15\n\ts_nop 7" : "+v"(acc) : "v"(a), "v"(b), "v"(sa), "v"(sb)); }
__device__ __forceinline__ i32x8 ld32(const char* p0, const char* p1) { const i32x4 lo = *(const i32x4*)p0, hi = *(const i32x4*)p1; return __builtin_shufflevector(lo, hi, 0, 1, 2, 3, 4, 5, 6, 7); }
__device__ __forceinline__ int koff(int key, int chunk) { return key * 128 + ((chunk ^ ((key >> 1) & 7)) << 4); }
__device__ __forceinline__ int voff(int n, int chunk) { return n * 64 + ((chunk ^ ((n >> 2) & 3)) << 4); }
__device__ __forceinline__ void qkt8(f32x16& p0, f32x16& p1, const char* Ks, const i32x8 (&qr)[2], int r32, int hi, int one, float off) {
#pragma unroll
    for (int r = 0; r < 16; ++r) { p0[r] = off; p1[r] = off; }
    const i32x8 a00 = ld32(Ks + koff(r32, 2 * hi), Ks + koff(r32, 2 * hi + 1)), a10 = ld32(Ks + koff(32 + r32, 2 * hi), Ks + koff(32 + r32, 2 * hi + 1));
    const i32x8 a01 = ld32(Ks + koff(r32, 4 + 2 * hi), Ks + koff(r32, 5 + 2 * hi)), a11 = ld32(Ks + koff(32 + r32, 4 + 2 * hi), Ks + koff(32 + r32, 5 + 2 * hi));
    mfma8_pre(p0, a00, qr[0], one, one); mfma8(p1, a10, qr[0], one, one);
    mfma8(p0, a01, qr[1], one, one); mfma8_post(p1, a11, qr[1], one, one);
}
template <bool FIRST>
__device__ __forceinline__ void partialSM8(f32x16& p0, f32x16& p1, float& off, float& alpha) {
    float pmax = p0[0];
#pragma unroll
    for (int r = 1; r < 16; ++r) pmax = fmaxf(pmax, p0[r]);
#pragma unroll
    for (int r = 0; r < 16; ++r) pmax = fmaxf(pmax, p1[r]);
    { auto rr = __builtin_amdgcn_permlane32_swap(__float_as_uint(pmax), __float_as_uint(pmax), false, false);
      pmax = fmaxf(__uint_as_float(rr[0]), __uint_as_float(rr[1])); }
    alpha = 1.f;
    if (FIRST || !__builtin_expect(__all(pmax <= 6.0f + THR8 * 1.4426950408889634f), 1)) {
        const float d = FIRST ? (pmax - 6.0f) : fmaxf(pmax - 6.0f, 0.f);
#pragma unroll
        for (int r = 0; r < 16; ++r) { p0[r] -= d; p1[r] -= d; }
        off -= d; if (!FIRST) alpha = __builtin_amdgcn_exp2f(-d);
    }
#pragma unroll
    for (int r = 0; r < 16; ++r) p0[r] = __builtin_amdgcn_exp2f(p0[r]);
}
__device__ __forceinline__ void finishSM8(f32x16& p0, f32x16& p1, float alpha, float& l_reg, i32x8& pa) {
#pragma unroll
    for (int r = 0; r < 16; ++r) p1[r] = __builtin_amdgcn_exp2f(p1[r]);
    float ps = 0;
#pragma unroll
    for (int r = 0; r < 16; ++r) ps += p0[r];
#pragma unroll
    for (int r = 0; r < 16; ++r) ps += p1[r];
    { auto rr = __builtin_amdgcn_permlane32_swap(__float_as_uint(ps), __float_as_uint(ps), false, false);
      ps = __uint_as_float(rr[0]) + __uint_as_float(rr[1]); }
    l_reg = l_reg * alpha + ps;
#pragma unroll
    for (int t = 0; t < 4; ++t) {
        pa[t] = (int)pk_fp8x4_nc(p0[4 * t], p0[4 * t + 1], p0[4 * t + 2], p0[4 * t + 3]);
        pa[4 + t] = (int)pk_fp8x4_nc(p1[4 * t], p1[4 * t + 1], p1[4 * t + 2], p1[4 * t + 3]); }
}
__device__ __forceinline__ void pv8(f32x16* o, const char* Vs, const i32x8& pa, int r32, int hi, int ep, int one) {
    const i32x8 b0 = ld32(Vs + voff(r32, 2 * hi), Vs + voff(r32, 2 * hi + 1)), b1 = ld32(Vs + voff(32 + r32, 2 * hi), Vs + voff(32 + r32, 2 * hi + 1));
    const i32x8 b2 = ld32(Vs + voff(64 + r32, 2 * hi), Vs + voff(64 + r32, 2 * hi + 1)), b3 = ld32(Vs + voff(96 + r32, 2 * hi), Vs + voff(96 + r32, 2 * hi + 1));
    mfma8_pre(o[0], pa, b0, ep, one); mfma8(o[1], pa, b1, ep, one); mfma8(o[2], pa, b2, ep, one); mfma8(o[3], pa, b3, ep, one);
}
constexpr float CREF = 104.5f, CHI = 104.5f + 8.0f * THR8 * 1.4426950408889634f, COFF0 = 56.5f;
__device__ __forceinline__ void mfma8u(f32x16& acc, const i32x8& a, const i32x8& b) { asm volatile("v_mfma_f32_32x32x64_f8f6f4 %0, %1, %2, %0" : "+v"(acc) : "v"(a), "v"(b)); }
__device__ __forceinline__ void mfma8u_pre(f32x16& acc, const i32x8& a, const i32x8& b) { asm volatile("s_nop 3\n\tv_mfma_f32_32x32x64_f8f6f4 %0, %1, %2, %0" : "+v"(acc) : "v"(a), "v"(b)); }
__device__ __forceinline__ void mfma8u_post(f32x16& acc, const i32x8& a, const i32x8& b) { asm volatile("v_mfma_f32_32x32x64_f8f6f4 %0, %1, %2, %0\n\ts_nop 15\n\ts_nop 7" : "+v"(acc) : "v"(a), "v"(b)); }
__device__ __forceinline__ void mfma8u_c(f32x16& d, const i32x8& a, const i32x8& b, const f32x16& c) { asm volatile("v_mfma_f32_32x32x64_f8f6f4 %0, %1, %2, %3" : "=&v"(d) : "v"(a), "v"(b), "v"(c)); }
__device__ __forceinline__ void qkt8c(f32x16& p0, f32x16& p1, const char* Ks, const i32x8 (&qr)[2], int r32, int hi, const f32x16& offv) {
    const i32x8 a00 = ld32(Ks + koff(r32, 2 * hi), Ks + koff(r32, 2 * hi + 1)), a10 = ld32(Ks + koff(32 + r32, 2 * hi), Ks + koff(32 + r32, 2 * hi + 1));
    const i32x8 a01 = ld32(Ks + koff(r32, 4 + 2 * hi), Ks + koff(r32, 5 + 2 * hi)), a11 = ld32(Ks + koff(32 + r32, 4 + 2 * hi), Ks + koff(32 + r32, 5 + 2 * hi));
    mfma8u_c(p0, a00, qr[0], offv); mfma8u_c(p1, a10, qr[0], offv);
    mfma8u(p0, a01, qr[1]); mfma8u_post(p1, a11, qr[1]);
}
template <bool FIRST>
__device__ __forceinline__ void smx8(f32x16& p0, f32x16& p1, float& offc, f32x16& offv, float& alpha, i32x8& pa) {
    float pmax = p0[0];
#pragma unroll
    for (int r = 1; r < 16; ++r) pmax = fmaxf(pmax, p0[r]);
#pragma unroll
    for (int r = 0; r < 16; ++r) pmax = fmaxf(pmax, p1[r]);
    { auto rr = __builtin_amdgcn_permlane32_swap(__float_as_uint(pmax), __float_as_uint(pmax), false, false);
      pmax = fmaxf(__uint_as_float(rr[0]), __uint_as_float(rr[1])); }
    alpha = 1.f;
    if (FIRST || !__builtin_expect(__all(pmax <= CHI), 1)) {
        const float d = FIRST ? (pmax - CREF) : fmaxf(pmax - CREF, 0.f);
#pragma unroll
        for (int r = 0; r < 16; ++r) { p0[r] -= d; p1[r] -= d; }
        offc -= d; if (!FIRST) alpha = __builtin_amdgcn_exp2f(-0.125f * d);
#pragma unroll
        for (int r = 0; r < 16; ++r) offv[r] = offc;
        asm volatile("s_nop 1" : "+v"(offv));
    }
#pragma unroll
    for (int t = 0; t < 4; ++t) {
        unsigned w0 = 0u, w1 = 0u;
#pragma unroll
        for (int b = 0; b < 4; ++b) { w0 = __builtin_amdgcn_cvt_pk_u8_f32(p0[4 * t + b], b, w0); w1 = __builtin_amdgcn_cvt_pk_u8_f32(p1[4 * t + b], b, w1); }
        pa[t] = (int)w0; pa[4 + t] = (int)w1; }
}
__device__ __forceinline__ void pv8c(f32x16* o, const char* Vs, const i32x8& pa, const i32x8& ones, int r32, int hi) {
    const i32x8 b0 = ld32(Vs + voff(r32, 2 * hi), Vs + voff(r32, 2 * hi + 1)), b1 = ld32(Vs + voff(32 + r32, 2 * hi), Vs + voff(32 + r32, 2 * hi + 1));
    const i32x8 b2 = ld32(Vs + voff(64 + r32, 2 * hi), Vs + voff(64 + r32, 2 * hi + 1)), b3 = ld32(Vs + voff(96 + r32, 2 * hi), Vs + voff(96 + r32, 2 * hi + 1));
    mfma8u_pre(o[0], pa, b0); mfma8u(o[1], pa, b1); mfma8u(o[2], pa, b2); mfma8u(o[3], pa, b3); mfma8u(o[4], pa, ones);
}
template <int MODE>
__device__ __forceinline__ void attn8_body(const unsigned char* __restrict__ Q8, const unsigned char* __restrict__ K8, const unsigned char* __restrict__ Vt,
                                           unsigned char* __restrict__ Ob, int NT, int nctx, int q0, float sink, char* lds) {
    int tid = threadIdx.x; asm volatile("" : "+v"(tid));
    const int wid = tid >> 6, lane = tid & 63, r32 = lane & 31, hi = lane >> 5;
    char* V_lds = lds; char* K_lds = lds + 2 * SHM8_V;
    float* ws = (float*)(lds + 2 * SHM8_V + 2 * SHM8_K) + wid * 64; float* li_l = ws; float* al_l = ws + 32;
    float offc = COFF0 + 2048.0f; f32x16 o[5] = {}; f32x16 offv;
#pragma unroll
    for (int r = 0; r < 16; ++r) offv[r] = offc;
    asm volatile("s_nop 1" : "+v"(offv));
    i32x8 qr[2];
    { const unsigned char* Qw = Q8 + (size_t)(wid * QBLK + r32) * MIXW + hi * 32;
      qr[0] = ld32((const char*)Qw, (const char*)Qw + 16); qr[1] = ld32((const char*)Qw + 64, (const char*)Qw + 80); }
    const int krow = tid >> 3, kch = tid & 7, kst = krow * 128 + ((kch ^ ((krow >> 1) & 7)) << 4);
    const int qpos = q0 + wid * QBLK + r32;
    const int bandX0 = (CTX + q0 - 128) / KVBLK;
    struct { u32x4 ks, vs; } sr_[2];
#define TIX(jt) ((MODE == 0 || (jt) < nctx) ? (jt) : (bandX0 + ((jt) - nctx) < TOK / KVBLK ? bandX0 + ((jt) - nctx) : TOK / KVBLK - 1))
#define SLOAD(i, jt) do { const int tx_ = TIX(jt); sr_[i].ks = *(const u32x4*)(K8 + (size_t)(tx_ * KVBLK + krow) * 256 + kch * 16); sr_[i].vs = *(const u32x4*)(Vt + (size_t)tx_ * 16384 + tid * 16); } while (0)
#define SWRITE(b, i) do { *(u32x4*)(K_lds + (b) * SHM8_K + kst) = sr_[i].ks; *(u32x4*)(V_lds + (b) * SHM8_V + tid * 16) = sr_[i].vs; } while (0)
#define RESC(a) do { if (__any((a) < 1.f)) { if (hi == 0) al_l[r32] = (a); asm volatile("s_waitcnt lgkmcnt(0)" ::: "memory"); \
    _Pragma("unroll") for (int r = 0; r < 16; ++r) { const float av_ = al_l[att::crow(r, hi)]; _Pragma("unroll") for (int d = 0; d < 5; ++d) o[d][r] *= av_; SBAR(); } } } while (0)
#define MASK(PA, PB, jt) do { if (MODE == 1 && (jt) >= nctx) att::apply_mask(PA, PB, q0 - 128 + ((jt) - nctx) * KVBLK, qpos, hi); } while (0)
#define STEP(t_, FIRST_, b_, set_) do { \
        SBAR(); qkt8c(p0, p1, K_lds + (b_) * SHM8_K, qr, r32, hi, offv); SBAR(); \
        if ((t_) + 1 < NT) { SWRITE(1 - (b_), set_); if ((t_) + 3 < NT) SLOAD(set_, (t_) + 3); } SBAR(); \
        MASK(p0, p1, t_); smx8<FIRST_>(p0, p1, offc, offv, al, pa); if (!(FIRST_)) RESC(al); SBAR(); \
        pv8c(o, V_lds + (b_) * SHM8_V, pa, ones, r32, hi); SBAR(); \
        __syncthreads(); } while (0)
    f32x16 p0, p1; float al; i32x8 pa;
    i32x8 ones; { int w1 = 0x38383838; ones = (i32x8){w1, w1, w1, w1, w1, w1, w1, w1}; asm volatile("" : "+v"(ones)); }
    SLOAD(0, 0); asm volatile("s_waitcnt vmcnt(0)" ::: "memory"); SWRITE(0, 0); SLOAD(1, 1); SLOAD(0, 2); __syncthreads();
    for (int t = 0; t < NT; t += 2) { STEP(t, false, 0, 1); STEP(t + 1, false, 1, 0); }
    asm volatile("s_nop 15\n\ts_nop 15" : "+v"(o[0]), "+v"(o[1]), "+v"(o[2]), "+v"(o[3]), "+v"(o[4]));
    if (MODE == 1) { if (hi == 0) li_l[r32] = __builtin_amdgcn_exp2f(sink * 1.4426950408889634f + 0.125f * (offc - COFF0)); asm volatile("s_waitcnt lgkmcnt(0)" ::: "memory"); }
    unsigned char* Ow = Ob + (long)(wid * QBLK) * MIXW;
#pragma unroll
    for (int r = 0; r < 16; ++r) { int orow = att::crow(r, hi);
        const float rl = W8_SCALE * __builtin_amdgcn_rcpf(MODE == 1 ? o[4][r] + li_l[orow] : o[4][r]);
        const unsigned w = pk_fp8x4((f32x4){o[0][r], o[1][r], o[2][r], o[3][r]} * rl);
#pragma unroll
        for (int d0 = 0; d0 < 4; ++d0) Ow[(long)orow * MIXW + d0 * 32 + r32] = (unsigned char)(w >> (8 * d0)); }
    asm volatile("s_waitcnt vmcnt(0) lgkmcnt(0)" ::: "memory");
    __syncthreads();
#undef STEP
#undef TIX
#undef SLOAD
#undef SWRITE
#undef RESC
#undef MASK
}
}

struct Args { const float* in[22]; float* out; unsigned char* ws; int ph_lo, ph_hi, li, pad; };
typedef const __attribute__((address_space(4))) Args* KArgs;
enum { I_X = 0, I_C, I_CTX, I_CCTX, I_WADA, I_BADA, I_N1G, I_N2G, I_WIN, I_POOLW, I_POOLS, I_QNG, I_KNG, I_SINK, I_WBR, I_WOUT, I_RW, I_RB, I_WG, I_WU, I_WD, I_FG };

__device__ __forceinline__ void ada_item(KArgs A, char* lds, int item) {
    const int tid = ltid(), wave = tid >> 6, lane = tid & 63;
    float* sil = (float*)lds;
    float* red = (float*)(lds + 16384);
    const float* cvec = A->in[I_C]; const float* ccvec = A->in[I_CCTX];
    for (int i = tid; i < DM; i += NTHR) { const float a = cvec[i], b = ccvec[i]; sil[i] = a * sigmoidf_(a); sil[DM + i] = b * sigmoidf_(b); }
    __syncthreads();
    const int l = item / 48, chunk = item % 48, col0 = chunk * 256 + lane * 4;
    const float* W = A->in[I_WADA] + (size_t)l * DM * ADA;
    f32x4 a0 = {0.f, 0.f, 0.f, 0.f}, a1 = {0.f, 0.f, 0.f, 0.f};
    const int d0 = wave * 256;
    for (int d = d0; d < d0 + 256; d += 8) {
        f32x4 w[8];
#pragma unroll
        for (int u = 0; u < 8; ++u) w[u] = *(const f32x4*)(W + (size_t)(d + u) * ADA + col0);
#pragma unroll
        for (int u = 0; u < 8; ++u) { const float s0 = sil[d + u], s1 = sil[DM + d + u]; a0 += s0 * w[u]; a1 += s1 * w[u]; }
    }
    *(f32x4*)(red + (wave * 2 + 0) * 256 + lane * 4) = a0;
    *(f32x4*)(red + (wave * 2 + 1) * 256 + lane * 4) = a1;
    __syncthreads();
    if (tid < 512) {
        const int w = tid >> 8, c = tid & 255;
        float s = A->in[I_BADA][(size_t)l * ADA + chunk * 256 + c];
#pragma unroll
        for (int k = 0; k < 8; ++k) s += red[(k * 2 + w) * 256 + c];
        ((float*)(A->ws + WS_MOD))[(size_t)(l * 2 + w) * ADA + chunk * 256 + c] = s;
    }
    __syncthreads();
}

struct CvtTile { const float* src; bf16_t* dst; int sp, dp, f8; };
constexpr int DENSE_TILES_L = 1280 + 384 + 256 + 16, DENSE_TILES = 2 * DENSE_TILES_L;
constexpr int MOE_TILES_L = 3 * 4096, MOE_TILES = DENSE_TILES_L + 2 * MOE_TILES_L  , CVT_BATCH = 2;
__device__ __forceinline__ void cvt_decode_dense(KArgs A, int t, CvtTile& c) {
    c.f8 = 0;
    const int l = t / DENSE_TILES_L; int r = t % DENSE_TILES_L;
    unsigned char* ws = A->ws;
    if (r < 1280) { const int tk = r / 80, tn = r % 80;
        c.src = A->in[I_WIN] + (size_t)l * DM * INW + (size_t)(tk * 128) * INW + tn * 128; c.sp = INW;
        { c.dst = (bf16_t*)(ws + WS_WIN + ((size_t)l * INW + tn * 128) * DM * 2 + tk * 128); c.dp = DM * 2; c.f8 = 1; }
        return; }
    r -= 1280;
    if (r < 384) { const int n = r / 128, q = r % 128, tk = q / 16, tn = q % 16;
        c.src = A->in[I_WBR] + ((size_t)(l * 3 + n) * MIXW + tk * 128) * DM + tn * 128; c.sp = DM;
        { c.dst = (bf16_t*)(ws + WS_WBR + (size_t)(l * 3 + n) * DM * MIXW * 2 + (size_t)(tn * 128) * MIXW + tk * 128); c.dp = MIXW; c.f8 = 1; }
        return; }
    r -= 384;
    if (r < 256) { const int tk = r / 16, tn = r % 16;
        c.src = A->in[I_WOUT] + ((size_t)l * DM + tk * 128) * DM + tn * 128; c.sp = DM;
        c.dst = (bf16_t*)(ws + WS_WOUT + (size_t)l * DM * DM * 2 + (size_t)(tn * 128) * DM + tk * 128); c.dp = DM; c.f8 = 1; return; }
    r -= 256;
    { const int g = r / 4, q = r % 4, tk = q / 2, tn = q % 2;
        c.src = A->in[I_POOLW] + ((size_t)(l * 4 + g) * 256 + tk * 128) * 256 + tn * 128; c.sp = 256;
        c.dst = (bf16_t*)(ws + WS_POOL) + ((size_t)(l * 4 + g) * 256 + tn * 128) * 256 + tk * 128; c.dp = 256; }
}
__device__ __forceinline__ void cvt_decode_moe(KArgs A, int t_, CvtTile& c) {
    if (t_ < DENSE_TILES_L) { cvt_decode_dense(A, DENSE_TILES_L + t_, c); return; }
    const int t = t_ - DENSE_TILES_L;
    const int l = t / MOE_TILES_L; int r = t % MOE_TILES_L;
    unsigned char* ws = A->ws;
    if (r < 8192) { const int s = r / 4096, q = r % 4096, e = q / 128, qq = q % 128, tk = qq / 8, tn = qq % 8;
        c.src = A->in[s ? I_WU : I_WG] + ((size_t)(l * NEXP + e) * DM + tk * 128) * FFD + tn * 128; c.sp = FFD;
        c.dst = (bf16_t*)(ws + WS_WGU + ((size_t)(l * NEXP + e) * 2048 + 256 * tn + 128 * s) * DM + tk * 128); c.dp = DM; c.f8 = 1; return; }
    r -= 8192;
    { const int e = r / 128, q = r % 128, tk = q / 16, tn = q % 16;
        c.src = A->in[I_WD] + ((size_t)(l * NEXP + e) * FFD + tk * 128) * DM + tn * 128; c.sp = DM;
        c.dst = (bf16_t*)(ws + WS_WD + ((((size_t)(l * NEXP + e) * 8 + (tn >> 1)) * 8 + tk) * 256 + (tn & 1) * 128) * 128); c.dp = 128; c.f8 = 1; }
}
template <bool NT> __device__ __forceinline__ void cvt_load(const CvtTile& c, int tid, f32x4 (&v)[8]) {
    const int lr = tid >> 5, lc = (tid & 31) * 4;
#pragma unroll
    for (int i = 0; i < 8; ++i) { const f32x4* p = (const f32x4*)(c.src + (size_t)(lr + 16 * i) * c.sp + lc); v[i] = NT ? __builtin_nontemporal_load(p) : *p; }
}
__device__ __forceinline__ void cvt_stage1(int tid, char* lds, const f32x4 (&v)[8]) {
    float* L1 = (float*)lds; const int lr = tid >> 5, lc = (tid & 31) * 4;
#pragma unroll
    for (int i = 0; i < 8; ++i) *(f32x4*)(L1 + (lr + 16 * i) * 132 + lc) = v[i];
    __syncthreads();
}
template <bool NT> __device__ __forceinline__ void cvt_stage2(const CvtTile& c, int tid, char* lds) {
    float* L1 = (float*)lds; char* L2 = lds + 128 * 132 * 4;
    if (c.f8) {
        { const int n = tid & 127, kq = tid >> 7;
#pragma unroll
          for (int cc = 0; cc < 4; ++cc) { const int kc = kq * 4 + cc; const float* s = L1 + (8 * kc) * 132 + n;
              u32x2 o; o.x = pk_fp8x4((f32x4){s[0], s[132], s[2 * 132], s[3 * 132]} * W8_SCALE); o.y = pk_fp8x4((f32x4){s[4 * 132], s[5 * 132], s[6 * 132], s[7 * 132]} * W8_SCALE);
              *(u32x2*)(L2 + n * 144 + kc * 8) = o; } }
        __syncthreads();
        { const int ch = tid & 7; unsigned char* d8 = (unsigned char*)c.dst;
#pragma unroll
          for (int i = 0; i < 2; ++i) { const int n = (tid >> 3) + 64 * i; const u32x4 o = *(const u32x4*)(L2 + n * 144 + ch * 16);
              u32x4* p = (u32x4*)(d8 + (size_t)n * c.dp + 16 * ch); if (NT) __builtin_nontemporal_store(o, p); else *p = o; } }
        return;
    }
    { const int n = tid & 127, kq = tid >> 7;
#pragma unroll
      for (int cc = 0; cc < 4; ++cc) { const int kc = kq * 4 + cc; const float* s = L1 + (8 * kc) * 132 + n;
          u32x4 o; o.x = cvt_pk_bf16(s[0], s[132]); o.y = cvt_pk_bf16(s[2 * 132], s[3 * 132]); o.z = cvt_pk_bf16(s[4 * 132], s[5 * 132]); o.w = cvt_pk_bf16(s[6 * 132], s[7 * 132]);
          *(u32x4*)(L2 + n * 272 + kc * 16) = o; } }
    __syncthreads();
    { const int kc = tid & 15;
#pragma unroll
      for (int i = 0; i < 4; ++i) { const int n = (tid >> 4) + 32 * i; const u32x4 o = *(const u32x4*)(L2 + n * 272 + kc * 16);
          u32x4* p = (u32x4*)(c.dst + (size_t)n * c.dp + 8 * kc); if (NT) __builtin_nontemporal_store(o, p); else *p = o; } }
}
__device__ __forceinline__ void cvt_static_dense(KArgs A, char* lds) {
    const int tid = ltid(), b = blockIdx.x, G = gridDim.x;
    int t, step, tend;
    if (G == 256) { if (b < 96) { t = b * 3; step = 1; tend = t + 3; } else { t = 288 + (b - 96); step = 160; tend = DENSE_TILES_L; } }
    else { t = b; step = G; tend = DENSE_TILES_L; }
    CvtTile c0, c1; f32x4 v0[8], v1[8];
    bool h0 = t < tend, h1 = (t + step) < tend;
    if (h0) { cvt_decode_dense(A, t, c0); cvt_load<false>(c0, tid, v0); }
    if (h1) { cvt_decode_dense(A, t + step, c1); cvt_load<false>(c1, tid, v1); }
    while (h0) {
        cvt_stage1(tid, lds, v0);
        CvtTile n0; const bool g0 = (t + 2 * step) < tend;
        if (g0) { cvt_decode_dense(A, t + 2 * step, n0); cvt_load<false>(n0, tid, v0); }
        cvt_stage2<false>(c0, tid, lds);
        if (!h1) break;
        cvt_stage1(tid, lds, v1);
        CvtTile n1; const bool g1 = (t + 3 * step) < tend;
        if (g1) { cvt_decode_dense(A, t + 3 * step, n1); cvt_load<false>(n1, tid, v1); }
        cvt_stage2<false>(c1, tid, lds);
        c0 = n0; c1 = n1; h0 = g0; h1 = g1; t += 2 * step;
    }
    __syncthreads();
}
__device__ __forceinline__ void cvt_queue(KArgs A, char* lds, int limit, int quota, unsigned* done, unsigned need) {
    const int tid = ltid();
    volatile int* qs = (volatile int*)(lds + AUX_OFF + 6144);
    unsigned* head = (unsigned*)(A->ws + WS_CTL) + CW_QHEAD;
    __syncthreads();
    if (tid == 0) {
        int first = MOE_TILES;
        if (need == 0u || __hip_atomic_load(done, __ATOMIC_RELAXED, __HIP_MEMORY_SCOPE_AGENT) < need) first = (int)__hip_atomic_fetch_add(head, 4u, __ATOMIC_RELAXED, __HIP_MEMORY_SCOPE_AGENT);
        qs[0] = first;
    }
    __syncthreads();
    int cur = qs[0], nxt = cur + 2, slot = 1, nb = 2, pend = 0;
    if (cur >= MOE_TILES) return;
    CvtTile c0, c1; f32x4 v0[8], v1[8];
    cvt_decode_moe(A, cur, c0); cvt_load<true>(c0, tid, v0);
    cvt_decode_moe(A, cur + 1, c1); cvt_load<true>(c1, tid, v1);
    while (cur < MOE_TILES) {
        bool more = false;
        if (tid == 0) { more = (nb < quota) && (nxt + 2 < limit) && (nxt < MOE_TILES);
            if (more && need != 0u) more = __hip_atomic_load(done, __ATOMIC_RELAXED, __HIP_MEMORY_SCOPE_AGENT) < need;
            if (more) pend = (int)__hip_atomic_fetch_add(head, 2u, __ATOMIC_RELAXED, __HIP_MEMORY_SCOPE_AGENT); }
        const bool hn = nxt < MOE_TILES;
        cvt_stage1(tid, lds, v0);
        CvtTile n0, n1;
        if (hn) { cvt_decode_moe(A, nxt, n0); cvt_load<true>(n0, tid, v0); }
        cvt_stage2<true>(c0, tid, lds);
        if (tid == 0) qs[slot] = more ? pend : MOE_TILES;
        cvt_stage1(tid, lds, v1);
        const int nn = qs[slot];
        if (hn) { cvt_decode_moe(A, nxt + 1, n1); cvt_load<true>(n1, tid, v1); }
        cvt_stage2<true>(c1, tid, lds);
        c0 = n0; c1 = n1; cur = nxt; nxt = nn; slot ^= 1; ++nb;
    }
    __syncthreads();
}
__device__ __forceinline__ void p0_prologue(KArgs A, char* lds) {
    const int tid = ltid(), G = gridDim.x, b = blockIdx.x;
    { const int lane = tid & 63, axis = lane >> 5, idx = lane & 31; float* tab = (float*)(A->ws + WS_ROPE);
      const float inv = exp2f(-(float)idx * (13.287712379549449f / 32.0f));
      for (int t = b * NWAVES + (tid >> 6); t < SEQ; t += G * NWAVES) { const float ang = (float)(axis ? (t & 63) : (t >> 6)) * inv;
          tab[(size_t)t * 128 + axis * 64 + idx] = cosf(ang); tab[(size_t)t * 128 + axis * 64 + 32 + idx] = sinf(ang); } }
    for (int it = b; it < 96; it += G) ada_item(A, lds, it);
    cvt_static_dense(A, lds);
}

__device__ __forceinline__ void moe_tile_table(KArgs A, int l, char* lds) {
    int* ts = (int*)(lds + AUX_OFF + 4096);
    if (ltid() == 0) {
        const unsigned* cnt = (const unsigned*)(A->ws + WS_CTL) + CW_CNT + l * 2048;
        int acc = 0, af = 0, ah = 0;
        for (int e = 0; e < NEXP; ++e) { const int cn = (int)__hip_atomic_load(cnt + 64 * e, __ATOMIC_RELAXED, __HIP_MEMORY_SCOPE_AGENT); const int nt_ = (cn + 255) >> 8;
            const int hf = (nt_ > 0 && (cn - (nt_ - 1) * 256) <= 128) ? 1 : 0;
            ts[e] = acc; ts[40 + e] = af; ts[80 + e] = ah; ts[120 + e] = cn; acc += nt_; af += nt_ - hf; ah += hf; }
        ts[NEXP] = acc; ts[40 + NEXP] = af; ts[80 + NEXP] = ah;
    }
    __syncthreads();
}

__device__ __forceinline__ void row_load_f32(const float* p, int lane, f32x4 (&v)[8]) {
#pragma unroll
    for (int j = 0; j < 8; ++j) v[j] = *(const f32x4*)(p + 4 * lane + 256 * j);
}
__device__ __forceinline__ void row_load_bf16(const bf16_t* p, int lane, f32x4 (&v)[8]) {
#pragma unroll
    for (int j = 0; j < 8; ++j) { const u32x2 x = *(const u32x2*)(p + 4 * lane + 256 * j); v[j] = (f32x4){bflo(x.x), bfhi(x.x), bflo(x.y), bfhi(x.y)}; }
}
__device__ __forceinline__ void moe_combine(KArgs A, int l, int row, int lane, f32x4 (&v)[8], const int* ts) {
    const unsigned* rt = (const unsigned*)(A->ws + WS_ROUTE) + (size_t)row * 8;
    const float w0 = __uint_as_float(rt[4]), w1 = __uint_as_float(rt[5]); const unsigned s0 = (unsigned)ts[rt[0]] * 256u + rt[2], s1 = (unsigned)ts[rt[1]] * 256u + rt[3];
    const bf16_t* y0 = (const bf16_t*)(A->ws + WS_Y2) + (size_t)s0 * DM; const bf16_t* y1 = (const bf16_t*)(A->ws + WS_Y2) + (size_t)s1 * DM;
    const float* g = (const float*)(A->ws + WS_MOD) + (size_t)(l * 2 + (row < CTX ? 1 : 0)) * ADA + 5 * DM;
#pragma unroll
    for (int j = 0; j < 8; ++j) { const int c = 4 * lane + 256 * j;
        const u32x2 a = *(const u32x2*)(y0 + c), b = *(const u32x2*)(y1 + c); const f32x4 gg = *(const f32x4*)(g + c);
        v[j].x += gg.x * (w0 * bflo(a.x) + w1 * bflo(b.x)); v[j].y += gg.y * (w0 * bfhi(a.x) + w1 * bfhi(b.x));
        v[j].z += gg.z * (w0 * bflo(a.y) + w1 * bflo(b.y)); v[j].w += gg.w * (w0 * bfhi(a.y) + w1 * bfhi(b.y)); }
}
__device__ __forceinline__ float row_rstd(const f32x4 (&v)[8]) {
    float s = 0.f;
#pragma unroll
    for (int j = 0; j < 8; ++j) s += (v[j].x * v[j].x + v[j].y * v[j].y) + (v[j].z * v[j].z + v[j].w * v[j].w);
    return rsqrtf(wave_sum(s) * (1.0f / DM) + RMS_EPS);
}

template <int MODE>
__device__ __forceinline__ void rows_phase(KArgs A, int l, char* lds) {
    const int lc = (MODE == 2) ? DEPTH - 1 : l - 1;
    if (MODE != 0) moe_tile_table(A, lc, lds);
    const int* ts = (const int*)(lds + AUX_OFF + 4096);
    const int tid = ltid(), lane = tid & 63, wave = tid >> 6, gw = blockIdx.x * NWAVES + wave, NGW = gridDim.x * NWAVES;
    float* pv = (float*)lds;
    { const int c = tid * 4;
      if (MODE == 2) *(f32x4*)(pv + c) = *(const f32x4*)(A->in[I_FG] + c);
      else { const f32x4 g = *(const f32x4*)(A->in[I_N1G] + (size_t)l * DM + c);
#pragma unroll
          for (int s_ = 0; s_ < 2; ++s_) { const float* mod = (const float*)(A->ws + WS_MOD) + (size_t)(l * 2 + s_) * ADA;
              *(f32x4*)(pv + (2 * s_) * DM + c) = g * (*(const f32x4*)(mod + DM + c) + 1.0f); *(f32x4*)(pv + (2 * s_ + 1) * DM + c) = *(const f32x4*)(mod + c); } }
      if (MODE != 0) {
#pragma unroll
          for (int s_ = 0; s_ < 2; ++s_) *(f32x4*)(pv + (4 + s_) * DM + c) = *(const f32x4*)((const float*)(A->ws + WS_MOD) + (size_t)(lc * 2 + s_) * ADA + 5 * DM + c); } }
    __syncthreads();
    const int first = (MODE == 2) ? CTX : 0, nrows = TOK - first, RPW = nrows / NGW;
#define ROW_K(k) ((k) < RPW ? first + gw + (k) * NGW : ((wave == 0 && RPW * NGW + (int)blockIdx.x + ((k) - RPW) * (int)gridDim.x < nrows) ? first + RPW * NGW + (int)blockIdx.x + ((k) - RPW) * (int)gridDim.x : TOK))
#define ROW_RT(r_, ra_, rb_) do { const unsigned* rt_ = (const unsigned*)(A->ws + WS_ROUTE) + (size_t)(r_) * 8; ra_ = *(const u32x4*)rt_; rb_ = *(const u32x2*)(rt_ + 4); } while (0)
#define ROW_ISSUE(r_, V, YA, YB, W0, W1, ra_, rb_) do { \
        if (MODE == 0) row_load_f32((r_) < CTX ? A->in[I_CTX] + (size_t)(r_) * DM : A->in[I_X] + (size_t)((r_) - CTX) * DM, lane, V); \
        else { _Pragma("unroll") for (int j = 0; j < 8; ++j) { const u32x2 x_ = *(const u32x2*)((const bf16_t*)(A->ws + WS_XA) + (size_t)(r_) * DM + 4 * lane + 256 * j); V[j].x = __uint_as_float(x_.x); V[j].y = __uint_as_float(x_.y); }   \
            const unsigned s0_ = (unsigned)ts[ra_.x] * 256u + ra_.z, s1_ = (unsigned)ts[ra_.y] * 256u + ra_.w; W0 = __uint_as_float(rb_.x); W1 = __uint_as_float(rb_.y); \
            const bf16_t* y0_ = (const bf16_t*)(A->ws + WS_Y2) + (size_t)s0_ * DM; const bf16_t* y1_ = (const bf16_t*)(A->ws + WS_Y2) + (size_t)s1_ * DM; \
            _Pragma("unroll") for (int j = 0; j < 8; ++j) { YA[j] = *(const u32x2*)(y0_ + 4 * lane + 256 * j); YB[j] = *(const u32x2*)(y1_ + 4 * lane + 256 * j); } } } while (0)
    auto body = [&](f32x4 (&v)[8], const u32x2 (&ya)[8], const u32x2 (&yb)[8], const float w0, const float w1, const int row) {
        const int s_ = row < CTX ? 1 : 0;
        if (MODE != 0) {
#pragma unroll
            for (int j = 0; j < 8; ++j) { const unsigned a_ = __float_as_uint(v[j].x), b_ = __float_as_uint(v[j].y); v[j] = (f32x4){bflo(a_), bfhi(a_), bflo(b_), bfhi(b_)}; }
#pragma unroll
            for (int j = 0; j < 8; ++j) { const f32x4 gg = *(const f32x4*)(pv + (4 + s_) * DM + 4 * lane + 256 * j); const u32x2 a = ya[j], b = yb[j];
                v[j].x += gg.x * (w0 * bflo(a.x) + w1 * bflo(b.x)); v[j].y += gg.y * (w0 * bfhi(a.x) + w1 * bfhi(b.x));
                v[j].z += gg.z * (w0 * bflo(a.y) + w1 * bflo(b.y)); v[j].w += gg.w * (w0 * bfhi(a.y) + w1 * bfhi(b.y)); }
        }
        float rstd = row_rstd(v);
        if (MODE == 2) {
#if PROBE_ATTN || PROBE_P2B
            { const float* pw = (const float*)(A->ws + WS_CTL) + CW_PRB; rstd *= 1.0f + sqrtf(pw[0] / pw[64]); }
#endif
            float* o = A->out + (size_t)(row - CTX) * DM;
#pragma unroll
            for (int j = 0; j < 8; ++j) { const int c = 4 * lane + 256 * j; *(f32x4*)(o + c) = v[j] * rstd * *(const f32x4*)(pv + c); }
        } else {
            if (MODE == 1) { bf16_t* xb = (bf16_t*)(A->ws + WS_XB) + (size_t)row * DM;
#pragma unroll
                for (int j = 0; j < 8; ++j) { u32x2 o; o.x = cvt_pk_bf16(v[j].x, v[j].y); o.y = cvt_pk_bf16(v[j].z, v[j].w); *(u32x2*)(xb + 4 * lane + 256 * j) = o; } }
#pragma unroll
            for (int j = 0; j < 8; ++j) { const int c = 4 * lane + 256 * j;
                const f32x4 y = v[j] * rstd * *(const f32x4*)(pv + (2 * s_) * DM + c) + *(const f32x4*)(pv + (2 * s_ + 1) * DM + c);
                *(unsigned*)(A->ws + WS_H8 + (size_t)row * DM + c) = pk_fp8x4(y); }
        }
    };
    f32x4 vA[8], vB[8]; u32x2 yaA[8], ybA[8], yaB[8], ybB[8]; float w0A = 0.f, w1A = 0.f, w0B = 0.f, w1B = 0.f;
    u32x4 raA = (u32x4){0u, 0u, 0u, 0u}, raB = raA; u32x2 rbA = (u32x2){0u, 0u}, rbB = rbA;
    int k = 0, rowA = ROW_K(0), rowB = ROW_K(1);
    if (MODE != 0) { if (rowA < TOK) ROW_RT(rowA, raA, rbA); if (rowB < TOK) ROW_RT(rowB, raB, rbB); }
    if (rowA < TOK) ROW_ISSUE(rowA, vA, yaA, ybA, w0A, w1A, raA, rbA);
    if (rowB < TOK) ROW_ISSUE(rowB, vB, yaB, ybB, w0B, w1B, raB, rbB);
    if (MODE != 0) { const int r2 = ROW_K(2), r3 = ROW_K(3); if (r2 < TOK) ROW_RT(r2, raA, rbA); if (r3 < TOK) ROW_RT(r3, raB, rbB); }
    for (;;) {
        if (rowA >= TOK) break;
        body(vA, yaA, ybA, w0A, w1A, rowA);
        __builtin_amdgcn_sched_barrier(0);
        rowA = ROW_K(k + 2);
        if (rowA < TOK) { ROW_ISSUE(rowA, vA, yaA, ybA, w0A, w1A, raA, rbA); if (MODE != 0) { const int r4 = ROW_K(k + 4); if (r4 < TOK) ROW_RT(r4, raA, rbA); } }
        __builtin_amdgcn_sched_barrier(0);
        if (rowB >= TOK) break;
        body(vB, yaB, ybB, w0B, w1B, rowB);
        __builtin_amdgcn_sched_barrier(0);
        rowB = ROW_K(k + 3);
        if (rowB < TOK) { ROW_ISSUE(rowB, vB, yaB, ybB, w0B, w1B, raB, rbB); if (MODE != 0) { const int r5 = ROW_K(k + 5); if (r5 < TOK) ROW_RT(r5, raB, rbB); } }
        __builtin_amdgcn_sched_barrier(0);
        k += 2;
    }
#undef ROW_K
#undef ROW_RT
#undef ROW_ISSUE
}
__device__ __forceinline__ void p1_norm1(KArgs A, int l, char* lds) { if (l == 0) rows_phase<0>(A, l, lds); else rows_phase<1>(A, l, lds); }
__device__ __forceinline__ void p_final(KArgs A, char* lds) { rows_phase<2>(A, DEPTH - 1, lds); }

__device__ __forceinline__ f32x4 ld_bf4(const bf16_t* p) { const u32x2 x = *(const u32x2*)p; return (f32x4){bflo(x.x), bfhi(x.x), bflo(x.y), bfhi(x.y)}; }
__device__ __forceinline__ void st_bf4(bf16_t* p, const f32x4 v) { u32x2 o; o.x = cvt_pk_bf16(v.x, v.y); o.y = cvt_pk_bf16(v.z, v.w); *(u32x2*)p = o; }
__device__ __forceinline__ f32x4 rope4(const f32x4 x, const f32x4 cs, const f32x4 sn, float sgn) {
    const int l4 = lane4_fresh(); f32x4 p; p.x = shx(x.x, 8, l4); p.y = shx(x.y, 8, l4); p.z = shx(x.z, 8, l4); p.w = shx(x.w, 8, l4);
    return x * cs + p * sn * sgn;
}
__device__ __forceinline__ float sum32(float v) { const int l4 = lane4_fresh(); v += shx(v, 1, l4); v += shx(v, 2, l4); v += shx(v, 4, l4); v += shx(v, 8, l4); v += shx(v, 16, l4); return v; }
__device__ __forceinline__ void p2b_post(KArgs A, int l, char* lds) {
    const int tid = ltid(), lane = tid & 63, gw = blockIdx.x * NWAVES + (tid >> 6), NGW = gridDim.x * NWAVES;
    unsigned* vx = (unsigned*)lds;
    const bf16_t* P = (const bf16_t*)(A->ws + WS_P);
    bf16_t* QG = (bf16_t*)(A->ws + WS_QG); bf16_t* QW = (bf16_t*)(A->ws + WS_QW); bf16_t* KG = (bf16_t*)(A->ws + WS_KG); bf16_t* KW = (bf16_t*)(A->ws + WS_KW);
    bf16_t* VG = (bf16_t*)(A->ws + WS_VG); bf16_t* VW = (bf16_t*)(A->ws + WS_VW); bf16_t* DP = (bf16_t*)(A->ws + WS_DP);
    unsigned char* Q8G = A->ws + WS_Q8G; unsigned char* Q8W = A->ws + WS_Q8W; unsigned char* K8G = A->ws + WS_K8G; unsigned char* K8W = A->ws + WS_K8W;
    unsigned char* VTG = A->ws + WS_VTG; unsigned char* VTW = A->ws + WS_VTW;
    const int j = lane & 31, q = j >> 3, dd = 4 * j;
    const float sgn = (q & 1) ? 1.f : -1.f;
    const f32x4 qg = *(const f32x4*)(A->in[I_QNG] + l * HD + dd), kg = *(const f32x4*)(A->in[I_KNG] + l * HD + dd);
    const float* tab = (const float*)(A->ws + WS_ROPE);
    for (int row = gw; row < TOK; row += NGW) {
        const bool lat = row >= CTX; const int t = row - CTX;
        const bf16_t* pr = P + (size_t)row * INW;
        const int sb = lat ? CTX : 0, tp = lat ? t : row, ls = lat ? SEQ : CTX;
        u32x2 rgq[4], rwq[4], ru[4], rgk, rwk, rgv, rwv, w2[2], w4[4], w8[8], w16[16];
#pragma unroll
        for (int hp = 0; hp < 4; ++hp) { rgq[hp] = *(const u32x2*)(pr + OFF_GQ + hp * 256 + 4 * lane); rwq[hp] = *(const u32x2*)(pr + OFF_WQ + hp * 256 + 4 * lane); ru[hp] = *(const u32x2*)(pr + hp * 256 + 4 * lane); }
        rgk = *(const u32x2*)(pr + OFF_GK + 4 * lane); rwk = *(const u32x2*)(pr + OFF_WK + 4 * lane); rgv = *(const u32x2*)(pr + OFF_GV + 4 * lane); rwv = *(const u32x2*)(pr + OFF_WV + 4 * lane);
#define P2B_WIN(arr, g, w) _Pragma("unroll") for (int i = 0; i < (w); ++i) { const int rr = tp - ((w) - 1) / 2 + i; const int rc = rr < 0 ? 0 : (rr >= ls ? ls - 1 : rr); arr[i] = *(const u32x2*)(P + (size_t)(sb + rc) * INW + (g) * 256 + lane * 4); }
        P2B_WIN(w2, 0, 2) P2B_WIN(w4, 1, 4) P2B_WIN(w8, 2, 8) P2B_WIN(w16, 3, 16)
#undef P2B_WIN
        f32x4 cs = {1.f, 1.f, 1.f, 1.f}, sn = {0.f, 0.f, 0.f, 0.f};
        if (lat) { const float* tp_ = tab + (size_t)t * 128 + (q >> 1) * 64 + 4 * (j & 7); cs = *(const f32x4*)tp_; sn = *(const f32x4*)(tp_ + 32); }
#define BF4(v) ((f32x4){bflo((v).x), bfhi((v).x), bflo((v).y), bfhi((v).y)})
#pragma unroll
        for (int hp = 0; hp < 4; ++hp) {
            f32x4 x = BF4(rgq[hp]);
            const float r = rsqrtf(sum32((x.x * x.x + x.y * x.y) + (x.z * x.z + x.w * x.w)) * (1.0f / HD) + RMS_EPS);
            x = x * r * qg;
            const f32x4 y = rope4(x, cs, sn, sgn);
            if (PROBE_ATTN) st_bf4(QG + (size_t)row * MIXW + hp * 256 + 4 * lane, y);
            *(unsigned*)(Q8G + (size_t)row * MIXW + hp * 256 + 4 * lane) = pk_fp8x4(y * (8.0f * att::SCALE * 1.4426950408889634f));
        }
        {
            f32x4 x = BF4(rgk);
            const float r = rsqrtf(sum32((x.x * x.x + x.y * x.y) + (x.z * x.z + x.w * x.w)) * (1.0f / HD) + RMS_EPS);
            x = x * r * kg;
            const f32x4 y = rope4(x, cs, sn, sgn);
            if (PROBE_ATTN) st_bf4(KG + (size_t)row * 256 + 4 * lane, y);
            *(unsigned*)(K8G + (size_t)row * 256 + 4 * lane) = pk_fp8x4(y);
        }
#pragma unroll
        for (int hp = 0; hp < 4; ++hp) { const f32x4 y = rope4(BF4(rwq[hp]), cs, sn, sgn);
            if (PROBE_ATTN) st_bf4(QW + (size_t)row * MIXW + hp * 256 + 4 * lane, y);
            *(unsigned*)(Q8W + (size_t)row * MIXW + hp * 256 + 4 * lane) = pk_fp8x4(y * (8.0f * att::SCALE * 1.4426950408889634f)); }
        { const f32x4 y = rope4(BF4(rwk), cs, sn, sgn);
          if (PROBE_ATTN) st_bf4(KW + (size_t)row * 256 + 4 * lane, y);
          *(unsigned*)(K8W + (size_t)row * 256 + 4 * lane) = pk_fp8x4(y); }
        if (PROBE_ATTN) { *(u32x2*)(VG + (size_t)row * 256 + lane * 4) = rgv; *(u32x2*)(VW + (size_t)row * 256 + lane * 4) = rwv; }
        {
            const int wv_ = tid >> 6;
            vx[(wv_ * 2 + 0) * 64 + lane] = pk_fp8x4(BF4(rgv));
            vx[(wv_ * 2 + 1) * 64 + lane] = pk_fp8x4(BF4(rwv));
        }
#define P2B_POOL(arr, g, w) { f32x4 s_ = {0.f, 0.f, 0.f, 0.f}; int cnt_ = 0; _Pragma("unroll") for (int i = 0; i < (w); ++i) { const int rr = tp - ((w) - 1) / 2 + i; const bool ok = (rr >= 0) && (rr < ls); \
            s_ += ok ? BF4(arr[i]) : (f32x4){0.f, 0.f, 0.f, 0.f}; cnt_ += ok ? 1 : 0; } \
            st_bf4(DP + (size_t)row * MIXW + (g) * 256 + lane * 4, s_ * (1.0f / (float)cnt_) - BF4(ru[g])); }
        P2B_POOL(w2, 0, 2) P2B_POOL(w4, 1, 4) P2B_POOL(w8, 2, 8) P2B_POOL(w16, 3, 16)
#undef P2B_POOL
#undef BF4
        __syncthreads();
        { const int R0 = row - (tid >> 6), tile = R0 >> 6, kap0 = R0 & 63, sb = 4 * ((kap0 & 31) >> 3) + 16 * (kap0 >> 5);
          const int buf = tid >> 8, n = tid & 255, kvh = n >> 7, nn = n & 127, ln = n >> 2, by = (n & 3) * 8;
          unsigned d0 = 0, d1 = 0;
#pragma unroll
          for (int w = 0; w < 4; ++w) { d0 |= ((vx[(w * 2 + buf) * 64 + ln] >> by) & 0xffu) << (8 * w); d1 |= ((vx[((w + 4) * 2 + buf) * 64 + ln] >> by) & 0xffu) << (8 * w); }
          unsigned char* img = (buf ? VTW : VTG) + ((size_t)tile * 2 + kvh) * 8192 + (size_t)nn * 64;
          const int sw_ = (nn >> 2) & 3;
          *(unsigned*)(img + ((((sb >> 4) ^ sw_)) << 4) + (sb & 15)) = d0;
          *(unsigned*)(img + (((((sb + 32) >> 4) ^ sw_)) << 4) + (sb & 15)) = d1; }
        __syncthreads();
    }
}

__device__ __forceinline__ void p6_norm2_route(KArgs A, int l, char* lds) {
    const int tid = ltid(), wave = tid >> 6, lane = tid & 63;
    float* hrow = (float*)lds;
    float* scr = (float*)(lds + AUX_OFF);
    const float* g2 = A->in[I_N2G] + (size_t)l * DM;
    const float* rw = A->in[I_RW]; const float* rb = A->in[I_RB];
    unsigned* cnt = (unsigned*)(A->ws + WS_CTL) + CW_CNT + l * 2048;
    for (int pass = blockIdx.x + (l == DEPTH - 1 ? CTX / 16 : 0); pass < TOK / 16; pass += gridDim.x) {
        const int r0 = pass * 16;
#pragma unroll 1
        for (int q = 0; q < 2; ++q) {
            const int rl = wave * 2 + q, row = r0 + rl;
            f32x4 v[8]; row_load_bf16((const bf16_t*)(A->ws + WS_XA) + (size_t)row * DM, lane, v);
            const float rstd = row_rstd(v);
            const float* mod = (const float*)(A->ws + WS_MOD) + (size_t)(l * 2 + (row < CTX ? 1 : 0)) * ADA;
            unsigned char* h = (unsigned char*)(A->ws + WS_H2) + (size_t)row * DM;
            f32x4 gg[8], sh[8], sc[8];
#pragma unroll
            for (int j = 0; j < 8; ++j) { const int c = 4 * lane + 256 * j; gg[j] = *(const f32x4*)(g2 + c); sh[j] = *(const f32x4*)(mod + 3 * DM + c); sc[j] = *(const f32x4*)(mod + 4 * DM + c); }
#pragma unroll
            for (int j = 0; j < 8; ++j) { const int c = 4 * lane + 256 * j;
                const f32x4 y = v[j] * rstd * gg[j] * (sc[j] + 1.0f) + sh[j];
                *(f32x4*)(hrow + rl * DM + c) = y;
                *(unsigned*)(h + c) = pk_fp8x4(y); }
        }
        __syncthreads();
        { const int e = tid & 31, ks = tid >> 5; const float* hk = hrow + ks * 128; const float* wk = rw + (size_t)(ks * 128) * NEXP + e;
          float acc[16];
#pragma unroll
          for (int r = 0; r < 16; ++r) acc[r] = 0.f;
          for (int k = 0; k < 128; k += 16) {
              float w[16];
#pragma unroll
              for (int u = 0; u < 16; ++u) w[u] = wk[(size_t)(k + u) * NEXP];
#pragma unroll
              for (int q = 0; q < 4; ++q) {
#pragma unroll
                  for (int r = 0; r < 16; ++r) { const f32x4 h4 = *(const f32x4*)(hk + r * DM + k + 4 * q);
                      acc[r] = fmaf(h4.x, w[4 * q], acc[r]); acc[r] = fmaf(h4.y, w[4 * q + 1], acc[r]); acc[r] = fmaf(h4.z, w[4 * q + 2], acc[r]); acc[r] = fmaf(h4.w, w[4 * q + 3], acc[r]); }
              }
          }
const int l4x = lane4_fresh();
#pragma unroll
          for (int r = 0; r < 16; ++r) acc[r] += shx(acc[r], 32, l4x);
          __syncthreads();
          if (lane < 32) {
#pragma unroll
              for (int r = 0; r < 16; ++r) hrow[(wave * 16 + r) * 32 + lane] = acc[r]; }
          __syncthreads();
          { const int rl = tid >> 5; float logit = 0.f;
#pragma unroll
            for (int wv = 0; wv < 8; ++wv) logit += hrow[(wv * 16 + rl) * 32 + e];
            scr[rl * 32 + e] = 1.0f / (1.0f + expf(-logit)); } }
        __syncthreads();
        if (tid < 16) {
            const int row = r0 + tid; const float* sc = scr + tid * 32;
            int bg = 0; float bgs = -1e30f;
            for (int g = 0; g < 4; ++g) { float m1 = -1e30f, m2 = -1e30f;
                for (int i = 0; i < 8; ++i) { const float s = sc[g * 8 + i] + rb[g * 8 + i]; if (s > m1) { m2 = m1; m1 = s; } else if (s > m2) m2 = s; }
                const float gs = m1 + m2; if (gs > bgs) { bgs = gs; bg = g; } }
            int i1 = 0, i2 = 0; float m1 = -1e30f, m2 = -1e30f;
            for (int i = 0; i < 8; ++i) { const float s = sc[bg * 8 + i] + rb[bg * 8 + i]; if (s > m1) { m2 = m1; i2 = i1; m1 = s; i1 = i; } else if (s > m2) { m2 = s; i2 = i; } }
            const int e0 = bg * 8 + i1, e1 = bg * 8 + i2; const float w0 = sc[e0], w1 = sc[e1], ws = w0 + w1;
            const unsigned p0 = __hip_atomic_fetch_add(cnt + 64 * e0, 1u, __ATOMIC_RELAXED, __HIP_MEMORY_SCOPE_AGENT);
            const unsigned p1 = __hip_atomic_fetch_add(cnt + 64 * e1, 1u, __ATOMIC_RELAXED, __HIP_MEMORY_SCOPE_AGENT);
            unsigned* rt = (unsigned*)(A->ws + WS_ROUTE) + (size_t)row * 8;
            rt[0] = (unsigned)e0; rt[1] = (unsigned)e1; rt[2] = p0; rt[3] = p1; rt[4] = __float_as_uint(w0 / ws); rt[5] = __float_as_uint(w1 / ws);
            unsigned* ix = (unsigned*)(A->ws + WS_XS); ix[(size_t)e0 * TOK + p0] = (unsigned)row; ix[(size_t)e1 * TOK + p1] = (unsigned)row;
        }
        __syncthreads();
    }
}

#ifndef PROBE_P2B
#define PROBE_P2B 0
#endif
#if PROBE_P2B
__device__ __forceinline__ void probe_p2b(KArgs A, int l) {
    const int tid = ltid(), lane = tid & 63, gw = blockIdx.x * NWAVES + (tid >> 6);
    const int ridx = gw;
    int row = (ridx < 64) ? ridx * 4 + (ridx & 3) : (ridx < 128 ? TOK - 1 - (ridx - 64) : CTX + (int)(((unsigned)ridx * 2654435761u >> 7) % (unsigned)SEQ));
    const bf16_t* P = (const bf16_t*)(A->ws + WS_P) + (size_t)row * INW;
    const bool lat = row >= CTX; const int t = row - CTX;
    float sd = 0.f, sr = 0.f;
    for (int hh = 0; hh < 20; ++hh) {
        int off; const bf16_t* O; bool nrm; const float* gn = nullptr;
        if (hh < 8) { off = OFF_GQ + hh * HD; O = (const bf16_t*)(A->ws + WS_QG) + (size_t)row * MIXW + hh * HD; nrm = true; gn = A->in[I_QNG] + l * HD; }
        else if (hh < 10) { off = OFF_GK + (hh - 8) * HD; O = (const bf16_t*)(A->ws + WS_KG) + (size_t)row * 256 + (hh - 8) * HD; nrm = true; gn = A->in[I_KNG] + l * HD; }
        else if (hh < 18) { off = OFF_WQ + (hh - 10) * HD; O = (const bf16_t*)(A->ws + WS_QW) + (size_t)row * MIXW + (hh - 10) * HD; nrm = false; }
        else { off = OFF_WK + (hh - 18) * HD; O = (const bf16_t*)(A->ws + WS_KW) + (size_t)row * 256 + (hh - 18) * HD; nrm = false; }
        float ss = 0.f; for (int d = 0; d < HD; ++d) { const float x = bf2f(P[off + d]); ss += x * x; }
        const float r = nrm ? 1.0f / sqrtf(ss / (float)HD + RMS_EPS) : 1.0f;
        for (int d = lane; d < HD; d += 64) {
            const float x = bf2f(P[off + d]) * r * (nrm ? gn[d] : 1.0f);
            float y = x;
            if (lat) { const int half = d >> 6, dd = d & 63, i = dd & 31; const float pos = half ? (float)(t & 63) : (float)(t >> 6);
                const float ang = pos * powf(10000.0f, -(float)i / 32.0f); const int pd = (dd < 32) ? d + 32 : d - 32;
                const float xp = bf2f(P[off + pd]) * r * (nrm ? gn[pd] : 1.0f); const float rot = (dd < 32) ? -xp : xp;
                y = x * cosf(ang) + rot * sinf(ang); }
            const float o = bf2f(O[d]); sd += (o - y) * (o - y); sr += y * y;
        }
    }
    {
        const int sb = lat ? CTX : 0, tp = lat ? t : row, ls = lat ? SEQ : CTX; const bf16_t* Pb = (const bf16_t*)(A->ws + WS_P);
        const bf16_t* DPr = (const bf16_t*)(A->ws + WS_DP) + (size_t)row * MIXW;
        for (int c = lane; c < MIXW; c += 64) { const int g = c >> 8, w = 2 << g; int lo = tp - (w - 1) / 2, hi = tp + w / 2 + 1; lo = lo < 0 ? 0 : lo; hi = hi > ls ? ls : hi;
            float s = 0.f; for (int rr = lo; rr < hi; ++rr) s += bf2f(Pb[(size_t)(sb + rr) * INW + c]);
            const float y = s / (float)(hi - lo) - bf2f(P[c]); const float o = bf2f(DPr[c]); sd += (o - y) * (o - y); sr += y * y; }
    }
    sd = wave_sum(sd); sr = wave_sum(sr);
    if (lane == 0) { float* pw = (float*)(A->ws + WS_CTL) + CW_PRB; atomicAdd(pw, sd); atomicAdd(pw + 64, sr); }
}
#endif

#ifndef PROBE_ATTN
#define PROBE_ATTN 0
#endif
#if PROBE_ATTN
__device__ __forceinline__ void probe_attn(KArgs A, int l, char* lds) {
    const int tid = ltid(), lane = tid & 63, wave = tid >> 6, gw = blockIdx.x * NWAVES + wave;
    float* qs = (float*)(lds + wave * 1024);
    const int type = gw & 1, h = (gw >> 1) & 7, ridx = gw >> 4, kvh = h >> 2;
    int row; bool isc = false;
    if (ridx < 8) { row = (ridx * 37) & 255; isc = true; if (l != 0) return; }
    else if (ridx < 40) { const int k = ridx - 8; row = CTX + ((k & 1) ? SEQ - 1 - (k >> 1) * 61 : (k >> 1) * 63); }
    else row = CTX + (int)(((unsigned)ridx * 2654435761u >> 8) % (unsigned)SEQ);
    const bf16_t* Q = (const bf16_t*)(A->ws + (type ? WS_QW : WS_QG)); const bf16_t* K = (const bf16_t*)(A->ws + (type ? WS_KW : WS_KG)); const bf16_t* V = (const bf16_t*)(A->ws + (type ? WS_VW : WS_VG));
    const unsigned char* O = A->ws + WS_YB + (size_t)(1 + type) * YB_STRIDE * 2;
    for (int d = lane; d < HD; d += 64) { qs[d] = bf2f(Q[(size_t)row * MIXW + h * HD + d]); qs[128 + d] = (float)(((d * 37 + 11) % 13) - 6); }
    asm volatile("s_waitcnt lgkmcnt(0)" ::: "memory");
    float num = 0.f, den = 0.f;
    const int t = row - CTX;
    const int nk = (type == 0) ? (isc ? CTX : TOK) : (isc ? CTX : CTX + 257);
    for (int j = lane; j < nk; j += 64) {
        int kr;
        if (type == 0 || j < CTX) kr = j; else { const int kp = t - 128 + (j - CTX); if (kp < 0 || kp >= SEQ) continue; kr = CTX + kp; }
        const bf16_t* kp_ = K + (size_t)kr * 256 + kvh * HD; const bf16_t* vp_ = V + (size_t)kr * 256 + kvh * HD;
        float dot = 0.f, vr = 0.f;
        for (int d = 0; d < HD; ++d) { dot += qs[d] * bf2f(kp_[d]); vr += qs[128 + d] * bf2f(vp_[d]); }
        const float p = expf(dot * 0.088388347648318440f); num += p * vr; den += p;
    }
    num = wave_sum(num); den = wave_sum(den);
    if (type == 1) den += expf(A->in[I_SINK][l * 8 + h]);
    const float naive = num / den;
    float fast = 0.f;
    for (int d = lane; d < HD; d += 64) fast += qs[128 + d] * (__builtin_amdgcn_cvt_f32_fp8((int)O[(size_t)row * MIXW + h * HD + d], 0) * (1.0f / 32.0f));
    fast = wave_sum(fast);
    if (lane == 0) { float* pw = (float*)(A->ws + WS_CTL) + CW_PRB; atomicAdd(pw, (naive - fast) * (naive - fast)); atomicAdd(pw + 64, naive * naive); }
}
#endif

struct SchedDense {
    int nM, nN, nwg, G, c; const char* A; const char* B; size_t at, bt; int pbase, pcut, pskip;
    __device__ __forceinline__ bool next(int i, pg8::Unit& u) const {
        const long L = (long)i * G + c; if (L >= nwg) return false;
        int wgid = (int)L; { const int q = nwg / 8, r = nwg % 8, xcd = wgid % 8, off = wgid / 8; wgid = (xcd < r ? xcd * (q + 1) : r * (q + 1) + (xcd - r) * q) + off; }
        const int nig = 8 * nN, gid = wgid / nig, fm = gid * 8, gsz = (nM - fm) < 8 ? (nM - fm) : 8;
        u.pm = fm + ((wgid % nig) % gsz); { const int pl = (wgid % nig) / gsz; u.pn = pbase + pl + (pl >= pcut ? pskip : 0); } u.e = 0; u.half = 0; u.a = A + (size_t)u.pm * at; u.b = B + (size_t)u.pn * bt; return true;
    }
};
__device__ __forceinline__ void xcd_pos(int c, int& mi, int& pn) { const int j = c >> 3; pn = j & 7; mi = 4 * (c & 7) + (j >> 3); }
struct SchedMerge {
    int npos, G, c; const char* Y; const char* W; int nbr, b0, esz;
    __device__ __forceinline__ bool next(int i, pg8::Unit& u) const {
        const int r = i / nbr, nb = b0 + i % nbr; int pm, pn;
        if (G == 256) { if (r == 0) { int mi; xcd_pos(c, mi, pn); pm = 1 + mi; } else if (r == 1 && c < npos - 256) { pm = 0; pn = c; } else return false; }
        else { const int pos = r * G + c; if (pos >= npos) return false; pm = (pos / 8 + 1) % 33; pn = pos % 8; }
        u.pm = pm; u.pn = pn; u.e = nb; u.half = 0;
        u.a = Y + (size_t)nb * YB_STRIDE * 2 + (size_t)u.pm * 256 * MIXW * esz; u.b = W + (size_t)nb * DM * MIXW * 2 + (size_t)u.pn * 256 * MIXW * esz; return true;
    }
};
struct SchedOut {
    int npos, G, c; const char* Am; const char* W;
    __device__ __forceinline__ bool next(int i, pg8::Unit& u) const {
        int pm, pn;
        if (G == 256) { if (i == 0) { int mi; xcd_pos(c, mi, pn); pm = 1 + mi; } else if (i == 1 && c < npos - 256) { pm = 0; pn = c; } else return false; }
        else { const int pos = i * G + c; if (pos >= npos) return false; pm = (pos / 8 + 1) % 33; pn = pos % 8; }
        u.pm = pm; u.pn = pn; u.e = 0; u.half = 0; u.a = Am + (size_t)u.pm * 256 * DM; u.b = W + (size_t)u.pn * 256 * DM; return true;
    }
};
struct SchedPool {
    int G, c; const char* Dp; const char* W;
    __device__ __forceinline__ bool next(int i, pg8::Unit& u) const {
        const int idx = i * G + c; if (idx < 0 || idx >= 132) return false;
        u.pm = idx / 4; u.e = idx % 4; u.pn = 0; u.half = 0; u.a = Dp + ((size_t)u.pm * 256 * MIXW + u.e * 256) * 2; u.b = W + (size_t)u.e * 256 * 256 * 2; return true;
    }
};
struct SchedMoe {
    int G, c; const int* ts; const char* Ab; const char* Wb; size_t at, wexp, wt; const unsigned* idx;
    __device__ __forceinline__ int a_row(const pg8::Unit& u, int r) const { const int pos = (u.pm - ts[u.e]) * 256 + r; return pos < ts[120 + u.e] ? (int)idx[(size_t)u.e * TOK + pos] : 0; }
    __device__ __forceinline__ int nunits() const { return ts[NEXP] * 8; }
    __device__ __forceinline__ bool next(int i, pg8::Unit& u) const {
        int j, pn_;
        if (G == 256) { int mi; xcd_pos(c, mi, pn_); if (i == ((ts[NEXP] - 1) >> 5)) mi = (mi & 3) * 8 + (mi >> 2);
            j = i * 32 + mi; if (j >= ts[NEXP]) return false; }
        else { const int L = i * G + c; if (L >= ts[NEXP] * 8) return false; j = L >> 3; pn_ = L & 7; }
        const int nf = ts[40 + NEXP]; int e = 0, gm, hf;
        if (j < nf) { for (int k = 1; k < NEXP; ++k) e += (ts[40 + k] <= j) ? 1 : 0; gm = ts[e] + (j - ts[40 + e]); hf = 0; }
        else { j -= nf; for (int k = 1; k < NEXP; ++k) e += (ts[80 + k] <= j) ? 1 : 0; gm = ts[e + 1] - 1; hf = 1; }
        u.pm = gm; u.pn = pn_; u.e = e; u.half = hf; u.a = Ab + (size_t)gm * at; u.b = Wb + (size_t)e * wexp + (size_t)u.pn * wt; return true;
    }
};

typedef f32x4 AccT[2][2][4][2];
__device__ __forceinline__ u32x4 pack8(const f32x4 v0, const f32x4 v1) { u32x4 w; w.x = cvt_pk_bf16(v0[0], v0[1]); w.y = cvt_pk_bf16(v0[2], v0[3]); w.z = cvt_pk_bf16(v1[0], v1[1]); w.w = cvt_pk_bf16(v1[2], v1[3]); return w; }
__device__ __forceinline__ f32x4 sig4(const f32x4 v) { return (f32x4){sigmoidf_(v[0]), sigmoidf_(v[1]), sigmoidf_(v[2]), sigmoidf_(v[3])}; }

struct EpiP {
    static constexpr bool PERM = true; bf16_t* P;
    __device__ __forceinline__ void operator()(const AccT& acc, const pg8::Unit& u, int wr, int wc, int fr, int fq, const float fs) const {
        const int row0 = u.pm * 256 + wr * 64 + fr, col0 = u.pn * 256 + wc * 32 + 8 * fq; const bool sg = u.pn >= 16;
#pragma unroll
        for (int ai = 0; ai < 2; ++ai)
#pragma unroll
            for (int m = 0; m < 4; ++m) { bf16_t* rowp = P + (size_t)(row0 + ai * 128 + m * 16) * INW + col0;
#pragma unroll
                for (int bj = 0; bj < 2; ++bj) { f32x4 v0 = acc[ai][bj][m][0] * fs, v1 = acc[ai][bj][m][1] * fs;
                    if (sg) { v0 = sig4(v0); v1 = sig4(v1); }
                    *(u32x4*)(rowp + bj * 128) = pack8(v0, v1); } }
    }
};
struct EpiPool {
    static constexpr bool PERM = true; unsigned char* Y; const float* ps;
    __device__ __forceinline__ void operator()(const AccT& acc, const pg8::Unit& u, int wr, int wc, int fr, int fq, const float fs) const {
        const int row0 = u.pm * 256 + wr * 64 + fr, col0 = u.e * 256 + wc * 32 + 8 * fq;
        f32x4 s[2][2];
#pragma unroll
        for (int bj = 0; bj < 2; ++bj) { s[bj][0] = *(const f32x4*)(ps + col0 + bj * 128) * W8_SCALE; s[bj][1] = *(const f32x4*)(ps + col0 + bj * 128 + 4) * W8_SCALE; }
#pragma unroll
        for (int ai = 0; ai < 2; ++ai)
#pragma unroll
            for (int m = 0; m < 4; ++m) { unsigned char* rowp = Y + (size_t)(row0 + ai * 128 + m * 16) * MIXW + col0;
#pragma unroll
                for (int bj = 0; bj < 2; ++bj) { u32x2 o8; o8.x = pk_fp8x4(acc[ai][bj][m][0] * s[bj][0]); o8.y = pk_fp8x4(acc[ai][bj][m][1] * s[bj][1]); *(u32x2*)(rowp + bj * 128) = o8; } }
    }
};
struct EpiMerge {
    static constexpr bool PERM = true; const bf16_t* P; bf16_t* MG; unsigned char* MG8;
    __device__ __forceinline__ void operator()(const AccT& acc, const pg8::Unit& u, int wr, int wc, int fr, int fq, const float fs) const {
        const int row0 = u.pm * 256 + wr * 64 + fr, col0 = u.pn * 256 + wc * 32 + 8 * fq, nb = u.e;
#pragma unroll
        for (int ai = 0; ai < 2; ++ai) {
            u32x4 gv[4][2], ov[4][2];
#pragma unroll
            for (int m = 0; m < 4; ++m) { const size_t row = (size_t)(row0 + ai * 128 + m * 16);
                const bf16_t* gp = P + row * INW + OFF_GATE + nb * DM + col0; const bf16_t* op = MG + row * DM + col0;
#pragma unroll
                for (int bj = 0; bj < 2; ++bj) { gv[m][bj] = *(const u32x4*)(gp + bj * 128); if (nb != 0) ov[m][bj] = *(const u32x4*)(op + bj * 128); } }
#pragma unroll
            for (int m = 0; m < 4; ++m) { const size_t ro = (size_t)(row0 + ai * 128 + m * 16) * DM + col0;
#pragma unroll
                for (int bj = 0; bj < 2; ++bj) { const u32x4 g = gv[m][bj];
                    f32x4 v0 = (acc[ai][bj][m][0] * fs) * (f32x4){bflo(g.x), bfhi(g.x), bflo(g.y), bfhi(g.y)}, v1 = (acc[ai][bj][m][1] * fs) * (f32x4){bflo(g.z), bfhi(g.z), bflo(g.w), bfhi(g.w)};
                    if (nb != 0) { const u32x4 o = ov[m][bj]; v0 += (f32x4){bflo(o.x), bfhi(o.x), bflo(o.y), bfhi(o.y)}; v1 += (f32x4){bflo(o.z), bfhi(o.z), bflo(o.w), bfhi(o.w)}; }
                    if (nb == 2) { u32x2 o8; o8.x = pk_fp8x4(v0 * MG_SCALE); o8.y = pk_fp8x4(v1 * MG_SCALE); *(u32x2*)(MG8 + ro + bj * 128) = o8; }
                    else { u32x4 o2; o2.x = cvt_pk_bf16(v0[0], v0[1]); o2.y = cvt_pk_bf16(v0[2], v0[3]); o2.z = cvt_pk_bf16(v1[0], v1[1]); o2.w = cvt_pk_bf16(v1[2], v1[3]); *(u32x4*)(MG + ro + bj * 128) = o2; } } }
        }
    }
};
struct EpiOut {
    static constexpr bool PERM = true; const float* xlat; const float* xctx; const bf16_t* xb16; const float* mod; bf16_t* XA;
    __device__ __forceinline__ void operator()(const AccT& acc, const pg8::Unit& u, int wr, int wc, int fr, int fq, const float fs) const {
        const int row0 = u.pm * 256 + wr * 64 + fr, col0 = u.pn * 256 + wc * 32 + 8 * fq; const bool isc = (u.pm == 0);
        const float* gv = mod + (isc ? ADA : 0) + 2 * DM + col0;
        f32x4 g[2][2];
#pragma unroll
        for (int bj = 0; bj < 2; ++bj)
#pragma unroll
            for (int n = 0; n < 2; ++n) g[bj][n] = *(const f32x4*)(gv + bj * 128 + n * 4) * fs;
        if (xb16 == nullptr) {
#pragma unroll
            for (int ai = 0; ai < 2; ++ai) {
                f32x4 xv[4][4];
#pragma unroll
                for (int m = 0; m < 4; ++m) { const int row = row0 + ai * 128 + m * 16;
                    const float* xp = (isc ? xctx + (size_t)row * DM : xlat + (size_t)(row - CTX) * DM) + col0;
#pragma unroll
                    for (int q = 0; q < 4; ++q) xv[m][q] = *(const f32x4*)(xp + (q >> 1) * 128 + (q & 1) * 4); }
#pragma unroll
                for (int m = 0; m < 4; ++m) { bf16_t* op = XA + (size_t)(row0 + ai * 128 + m * 16) * DM + col0;
#pragma unroll
                    for (int bj = 0; bj < 2; ++bj) *(u32x4*)(op + bj * 128) = pack8(xv[m][2 * bj] + g[bj][0] * acc[ai][bj][m][0], xv[m][2 * bj + 1] + g[bj][1] * acc[ai][bj][m][1]); }
            }
        } else {
#pragma unroll
            for (int ai = 0; ai < 2; ++ai) {
                u32x4 xr[4][2];
#pragma unroll
                for (int m = 0; m < 4; ++m) { const bf16_t* xp = xb16 + (size_t)(row0 + ai * 128 + m * 16) * DM + col0;
#pragma unroll
                    for (int bj = 0; bj < 2; ++bj) xr[m][bj] = *(const u32x4*)(xp + bj * 128); }
#pragma unroll
                for (int m = 0; m < 4; ++m) { bf16_t* op = XA + (size_t)(row0 + ai * 128 + m * 16) * DM + col0;
#pragma unroll
                    for (int bj = 0; bj < 2; ++bj) { const u32x4 x = xr[m][bj];
                        *(u32x4*)(op + bj * 128) = pack8((f32x4){bflo(x.x), bfhi(x.x), bflo(x.y), bfhi(x.y)} + g[bj][0] * acc[ai][bj][m][0], (f32x4){bflo(x.z), bfhi(x.z), bflo(x.w), bfhi(x.w)} + g[bj][1] * acc[ai][bj][m][1]); } }
            }
        }
    }
};
struct EpiMoe1 {
    static constexpr bool PERM = true; unsigned char* ACT;
    __device__ __forceinline__ void operator()(const AccT& acc, const pg8::Unit& u, int wr, int wc, int fr, int fq, const float fs) const {
        const int row0 = u.pm * 256 + wr * 64 + fr, col0 = u.pn * 128 + wc * 32 + 8 * fq;
#pragma unroll
        for (int ai = 0; ai < 2; ++ai) { if (ai == 1 && u.half) break;
#pragma unroll
            for (int m = 0; m < 4; ++m) { u32x2 o;
                { const f32x4 gt = acc[ai][0][m][0] * fs, up = acc[ai][1][m][0] * (fs * ACT_SCALE); o.x = pk_fp8x4(gt * sig4(gt) * up); }
                { const f32x4 gt = acc[ai][0][m][1] * fs, up = acc[ai][1][m][1] * (fs * ACT_SCALE); o.y = pk_fp8x4(gt * sig4(gt) * up); }
                *(u32x2*)(ACT + (size_t)(row0 + ai * 128 + m * 16) * FFD + col0) = o; } }
    }
};
struct EpiMoe2 {
    static constexpr bool PERM = true; bf16_t* Y;
    __device__ __forceinline__ void operator()(const AccT& acc, const pg8::Unit& u, int wr, int wc, int fr, int fq, const float fs) const {
        const int row0 = u.pm * 256 + wr * 64 + fr, col0 = u.pn * 256 + wc * 32 + 8 * fq;
#pragma unroll
        for (int ai = 0; ai < 2; ++ai) { if (ai == 1 && u.half) break;
#pragma unroll
            for (int m = 0; m < 4; ++m) { bf16_t* rowp = Y + (size_t)(row0 + ai * 128 + m * 16) * DM + col0;
#pragma unroll
                for (int bj = 0; bj < 2; ++bj) *(u32x4*)(rowp + bj * 128) = pack8(acc[ai][bj][m][0] * fs, acc[ai][bj][m][1] * fs); } }
    }
};

#define TAIL_FILL(k, nbusy_) do { const int nbz_ = (nbusy_); unsigned* dn_ = (unsigned*)(ws + WS_CTL) + CW_DONE + 64 * (l * 8 + (k)); \
    if (nbz_ != 0) { if (bx < nbz_) { if (threadIdx.x == 0) __hip_atomic_fetch_add(dn_, 1u, __ATOMIC_RELAXED, __HIP_MEMORY_SCOPE_AGENT); } else cvt_queue(ap, lds, MOE_TILES, 1 << 30, dn_, (unsigned)nbz_); } } while (0)
#ifndef TF_P2
#define TF_P2 1
#endif
#ifndef TF_P45
#define TF_P45 1
#endif
constexpr int NPHASE = 20;
__global__ void __launch_bounds__(NTHR, 2) mk_fwd(Args args) {
    extern __shared__ __attribute__((aligned(16))) unsigned char lds_raw[];
    LAS unsigned char* ldsL = (LAS unsigned char*)lds_raw; char* lds = (char*)lds_raw;
    volatile LAS unsigned* MISC = (volatile LAS unsigned*)(ldsL + MISC_OFF);
    const int tid = threadIdx.x;
    if (tid < 32) MISC[tid] = 0u;
    __syncthreads();
    XcdBarrier bar; const int lo = args.ph_lo, hi = args.ph_hi; { unsigned char* ws = args.ws; bar.bar = (unsigned*)(ws + WS_CTL) + CW_BAR + args.li * XCD_BAR_WORDS; bar.x = 0; bar.st = nullptr;
    if (hi - lo > 1) bar = xcd_barrier_post((unsigned*)(ws + WS_CTL) + CW_BAR + args.li * XCD_BAR_WORDS, MISC + 8); }
#ifndef PH_MASK
#define PH_MASK 0xFFFFFFFFu
#endif
#define PHK(k) (((k) == 0) ? 0 : ((k) == NPHASE - 1) ? 10 : (((k) - 1) % 9) + 1)
#define IN(k) (((PH_MASK >> PHK(k)) & 1u) && lo <= (k) && (k) < hi)
#define SEAM(k) do { if (IN(k) && IN((k) + 1)) xcd_barrier(bar); } while (0)
#ifndef REPEAT_MASK
#define REPEAT_MASK 0u
#endif
#define NREP(bit) ((((REPEAT_MASK) >> (bit)) & 1u) ? 2 : 1)
#define REPB(bit) for (int rep_ = 0; rep_ < NREP(bit); ++rep_, (rep_ < NREP(bit) ? xcd_barrier(bar) : (void)0))

    REPB(0) if (IN(0)) { KArgs ap = (KArgs)__builtin_amdgcn_kernarg_segment_ptr(); asm volatile("" : "+s"(ap)); p0_prologue(ap, lds); }
    SEAM(0);

#define LAUNDER() KArgs ap = (KArgs)__builtin_amdgcn_kernarg_segment_ptr(); int l = l_; asm volatile("" : "+s"(ap), "+s"(l)); const int G = gridDim.x, bx = blockIdx.x; unsigned char* const ws = ap->ws; (void)G; (void)bx; (void)ws
    for (int l_ = 0; l_ < DEPTH; ++l_) {
        const int pb = 1 + 9 * l_;
        REPB(1) if (IN(pb + 0)) { LAUNDER(); p1_norm1(ap, l, lds); }
        SEAM(pb + 0);
        REPB(2) if (IN(pb + 1)) { LAUNDER();
            SchedDense S{TOK / 256, 40, (TOK / 256) * 40, G, bx, (const char*)(ws + WS_H8), (const char*)(ws + WS_WIN) + (size_t)l * INW * DM * 2, (size_t)256 * DM, (size_t)256 * DM * 2, 0, 1 << 20, 0};
            EpiP E{(bf16_t*)(ws + WS_P)};
            pg8::gemm_phase<EpiP, SchedDense, false, true>(ldsL, pg8::Gemm{DM, DM * 2, DM, E8M0_W, E8M0_ONE}, S, E);
            if (TF_P2) TAIL_FILL(0, S.nwg % G);
        }
        SEAM(pb + 1);
        REPB(3) if (IN(pb + 2)) { LAUNDER(); p2b_post(ap, l, lds); }
        SEAM(pb + 2);
#if PROBE_P2B
        if (IN(pb + 2)) { LAUNDER(); probe_p2b(ap, l); }
        SEAM(pb + 2);
#endif
        REPB(4) if (IN(pb + 3)) { LAUNDER();
            const bf16_t* QG = (const bf16_t*)(ws + WS_QG); const bf16_t* QW = (const bf16_t*)(ws + WS_QW);
            const bf16_t* KG = (const bf16_t*)(ws + WS_KG); const bf16_t* VG = (const bf16_t*)(ws + WS_VG);
            const bf16_t* KW = (const bf16_t*)(ws + WS_KW); const bf16_t* VW = (const bf16_t*)(ws + WS_VW);
            unsigned char* Y1 = ws + WS_YB + YB_STRIDE * 2; unsigned char* Y2b = ws + WS_YB + 2 * YB_STRIDE * 2;
            const int nitem = (l == 0) ? 264 : 256;
#ifndef P3_PARTS
#define P3_PARTS 7
#endif
            float mfix;
            { const float* qg_ = ap->in[I_QNG] + l * HD; const float* kg_ = ap->in[I_KNG] + l * HD; float a = 0.f, b = 0.f;
              for (int d = 0; d < HD; ++d) { a = fmaxf(a, fabsf(qg_[d])); b = fmaxf(b, fabsf(kg_[d])); }
              mfix = 1.03f * (float)HD * a * b; }
            if (P3_PARTS & 1) for (int it = bx; it < nitem; it += G) {
                const int h = it & 7, kvh = h >> 2; const bool isc = it >= 256; const int q0 = isc ? 0 : (it >> 3) * 256; const size_t r0 = isc ? 0 : (size_t)(CTX + q0);
                att8::attn8_body<0>(ws + WS_Q8G + r0 * MIXW + h * HD, ws + WS_K8G + kvh * HD, ws + WS_VTG + kvh * 8192, Y1 + r0 * MIXW + h * HD, isc ? 4 : TOK / 64, 0, q0, 0.f, lds);
            }
            if (P3_PARTS & 2) for (int it = bx; it < nitem; it += G) {
                const int h = it & 7, kvh = h >> 2; const bool isc = it >= 256; const int q0 = isc ? 0 : (it >> 3) * 256; const size_t r0 = isc ? 0 : (size_t)(CTX + q0);
                att8::attn8_body<1>(ws + WS_Q8W + r0 * MIXW + h * HD, ws + WS_K8W + kvh * HD, ws + WS_VTW + kvh * 8192, Y2b + r0 * MIXW + h * HD, isc ? 4 : 12, 4, q0, ap->in[I_SINK][l * 8 + h], lds);
            }
            SchedPool S{G, bx - 8, (const char*)(ws + WS_DP), (const char*)(ws + WS_POOL) + (size_t)l * 4 * 256 * 256 * 2};
            EpiPool E{ws + WS_YB, ap->in[I_POOLS] + (size_t)l * MIXW};
            if (P3_PARTS & 4) pg8::gemm_phase<EpiPool, SchedPool>(ldsL, pg8::Gemm{MIXW, 256, 256}, S, E);
            if (G == 256) { unsigned* dn_ = (unsigned*)(ws + WS_CTL) + CW_DONE + 64 * (l * 8 + 5);
                if (bx >= 8 && bx < 140) { if (threadIdx.x == 0) __hip_atomic_fetch_add(dn_, 1u, __ATOMIC_RELAXED, __HIP_MEMORY_SCOPE_AGENT); } else cvt_queue(ap, lds, MOE_TILES, 1 << 30, dn_, 132u); }
        }
        SEAM(pb + 3);
#if PROBE_ATTN
        if (IN(pb + 3)) { LAUNDER(); probe_attn(ap, l, lds); }
        SEAM(pb + 3);
#endif
        REPB(5) if (IN(pb + 4)) { LAUNDER();
            SchedMerge S{(l == 0) ? 264 : 256, G, bx, (const char*)(ws + WS_YB), (const char*)(ws + WS_WBR) + (size_t)l * 3 * DM * MIXW * 2, 3, 0, 1};
            EpiMerge E{(const bf16_t*)(ws + WS_P), (bf16_t*)(ws + WS_MG), ws + WS_MG8};
            pg8::gemm_phase<EpiMerge, SchedMerge, false, true>(ldsL, pg8::Gemm{MIXW, MIXW, MIXW, E8M0_W, E8M0_W}, S, E);
            if (TF_P45) TAIL_FILL(1, S.npos % G);
        }
        SEAM(pb + 4);
        REPB(6) if (IN(pb + 5)) { LAUNDER(); const float* mod = (const float*)(ws + WS_MOD) + (size_t)l * 2 * ADA;
            SchedOut S{(l == 0) ? 264 : 256, G, bx, (const char*)(ws + WS_MG8), (const char*)(ws + WS_WOUT) + (size_t)l * DM * DM * 2};
            EpiOut E{ap->in[I_X], ap->in[I_CTX], l == 0 ? (const bf16_t*)nullptr : (const bf16_t*)(ws + WS_XB), mod, (bf16_t*)(ws + WS_XA)};
            pg8::gemm_phase<EpiOut, SchedOut, false, true>(ldsL, pg8::Gemm{DM, DM, DM, E8M0_W, E8M0_MG}, S, E);
            if (TF_P45) TAIL_FILL(2, S.npos % G);
        }
        SEAM(pb + 5);
        REPB(7) if (IN(pb + 6)) { LAUNDER(); p6_norm2_route(ap, l, lds); cvt_queue(ap, lds, DENSE_TILES_L + (l + 1) * MOE_TILES_L, 1 << 30, nullptr, 0u); }
        SEAM(pb + 6);
        REPB(8) if (IN(pb + 7)) { LAUNDER();
            moe_tile_table(ap, l, lds);
            SchedMoe S{G, bx, (const int*)(lds + AUX_OFF + 4096), (const char*)(ws + WS_H2), (const char*)(ws + WS_WGU) + (size_t)l * NEXP * 2048 * DM, (size_t)0, (size_t)2048 * DM, (size_t)256 * DM, (const unsigned*)(ws + WS_XS)};
            EpiMoe1 E{(unsigned char*)(ws + WS_ACT)};
            pg8::gemm_phase<EpiMoe1, SchedMoe, true, true>(ldsL, pg8::Gemm{DM, DM, DM, E8M0_W, E8M0_ONE}, S, E);
        }
        SEAM(pb + 7);
        REPB(9) if (IN(pb + 8)) { LAUNDER();
            moe_tile_table(ap, l, lds);
            SchedMoe S{G, bx, (const int*)(lds + AUX_OFF + 4096), (const char*)(ws + WS_ACT), (const char*)(ws + WS_WD) + (size_t)l * NEXP * DM * FFD, (size_t)256 * FFD, (size_t)DM * FFD, (size_t)256 * FFD, nullptr};
            EpiMoe2 E{(bf16_t*)(ws + WS_Y2)};
            pg8::gemm_phase<EpiMoe2, SchedMoe, false, true>(ldsL, pg8::Gemm{FFD, 128, FFD, E8M0_W, E8M0_ACT, 32768}, S, E);
        }
        SEAM(pb + 8);
    }
    REPB(10) if (IN(NPHASE - 1)) { KArgs ap = (KArgs)__builtin_amdgcn_kernarg_segment_ptr(); asm volatile("" : "+s"(ap)); p_final(ap, lds); }
#undef IN
#undef SEAM
}

extern "C" void kernel_launch(void* const* d_in, const int* in_sizes, int n_in, void* d_out, int out_size, void* d_ws, size_t ws_size, hipStream_t stream) {
    static int grid = 0;
    if (grid == 0) {
        if (n_in != 22 || out_size != SEQ * DM || ws_size < WS_END) { fprintf(stderr, "kernel_launch: shape/workspace mismatch (n_in %d out %d ws %zu need %zu)\n", n_in, out_size, ws_size, (size_t)WS_END); grid = -1; return; }
        int dev = 0, cus = 0, per_cu = 0;
        if (hipGetDevice(&dev) != hipSuccess || hipDeviceGetAttribute(&cus, hipDeviceAttributeMultiprocessorCount, dev) != hipSuccess) { grid = -1; return; }
        if (hipFuncSetAttribute((const void*)mk_fwd, hipFuncAttributeMaxDynamicSharedMemorySize, LDS_BYTES) != hipSuccess) { fprintf(stderr, "kernel_launch: hipFuncSetAttribute failed\n"); grid = -1; return; }
        if (hipOccupancyMaxActiveBlocksPerMultiprocessor(&per_cu, (const void*)mk_fwd, NTHR, LDS_BYTES) != hipSuccess || per_cu < 1) { fprintf(stderr, "kernel_launch: occupancy query reports %d\n", per_cu); per_cu = 1; }
        (void)hipGetLastError();
        grid = cus;
        if (grid > 256) grid = 256;
    }
    if (grid < 0) return;
    (void)hipMemsetAsync((char*)d_ws + WS_CTL, 0, CTL_ZERO_BYTES, stream);
    Args a{};
    for (int i = 0; i < 22; ++i) a.in[i] = (const float*)d_in[i];
    a.out = (float*)d_out; a.ws = (unsigned char*)d_ws; a.pad = 0;
#if MK_PER_PHASE
    for (int p = 0; p < NPHASE; ++p) { a.ph_lo = p; a.ph_hi = p + 1; a.li = 0; hipLaunchKernelGGL(mk_fwd, dim3(grid), dim3(NTHR), LDS_BYTES, stream, a); }
#else
    a.ph_lo = 0; a.ph_hi = NPHASE; a.li = 0;
    hipLaunchKernelGGL(mk_fwd, dim3(grid), dim3(NTHR), LDS_BYTES, stream, a);
#endif
    const hipError_t le = hipPeekAtLastError();
    if (le != hipSuccess) fprintf(stderr, "kernel_launch: launch failed: %s\n", hipGetErrorName(le));
}
```

```cpp
#include <hip/hip_runtime.h>
#include <cstdio>
#include <cstdint>

#ifndef PROBE_ATTN
#define PROBE_ATTN 0
#endif
#ifndef MK_PER_PHASE
#define MK_PER_PHASE 0
#endif

constexpr int DM = 2048, SEQ = 8192, CTX = 256, TOK = SEQ + CTX, DEPTH = 2;
constexpr int HD = 128, MIXW = 1024, INW = 10240, NEXP = 32, FFD = 1024;
constexpr int OFF_GQ = 1024, OFF_GK = 2048, OFF_GV = 2304, OFF_WQ = 2560, OFF_WK = 3584, OFF_WV = 3840, OFF_GATE = 4096;
constexpr int ADA = 6 * DM;
constexpr float RMS_EPS = 1e-6f;
constexpr int XS_ROWS = 25088;

constexpr size_t MiB = 1u << 20;
constexpr size_t WS_CTL = 0, CTL_ZERO_BYTES = 2 * MiB;
constexpr size_t WS_MOD = 2 * MiB;
constexpr size_t WS_WIN = 4 * MiB;
constexpr size_t WS_WBR = 84 * MiB;
constexpr size_t WS_WOUT = 108 * MiB;
constexpr size_t WS_POOL = 124 * MiB;
constexpr size_t WS_WGU = 126 * MiB;
constexpr size_t WS_WD = 638 * MiB;
constexpr size_t WS_XA = 894 * MiB;
constexpr size_t WS_XB = 960 * MiB;
constexpr size_t WS_H = 1026 * MiB;
constexpr size_t WS_P = 1059 * MiB;
constexpr size_t WS_DP = 1224 * MiB;
constexpr size_t WS_QG = 1241 * MiB;
constexpr size_t WS_QW = 1258 * MiB;
constexpr size_t WS_KG = 1275 * MiB;
constexpr size_t WS_VG = 1280 * MiB;
constexpr size_t WS_KW = 1285 * MiB;
constexpr size_t WS_VW = 1290 * MiB;
constexpr size_t WS_YB = 1295 * MiB;
constexpr size_t WS_MG8 = 1345 * MiB;
constexpr size_t WS_MG = 1411 * MiB;
constexpr size_t WS_H2 = 1444 * MiB;
constexpr size_t WS_XS = 1477 * MiB;
constexpr size_t WS_ACT = 1575 * MiB;
constexpr size_t WS_Y2 = 1624 * MiB;
constexpr size_t WS_ROUTE = 1722 * MiB;
constexpr size_t WS_ROPE = 1724 * MiB;
constexpr size_t WS_Q8G = 1728 * MiB;
constexpr size_t WS_Q8W = 1737 * MiB;
constexpr size_t WS_K8G = 1746 * MiB;
constexpr size_t WS_K8W = 1749 * MiB;
constexpr size_t WS_VTG = 1752 * MiB;
constexpr size_t WS_VTW = 1755 * MiB;
constexpr size_t WS_H8 = 1758 * MiB;
constexpr size_t WS_END = 1776 * MiB;
constexpr size_t YB_STRIDE = (size_t)TOK * MIXW;

constexpr float ACT_SCALE = 8.0f;
constexpr float W8_SCALE = 32.0f;
constexpr int E8M0_ONE = 0x7F7F7F7F, E8M0_ACT = 0x7C7C7C7C  , E8M0_W = 0x7A7A7A7A  , E8M0_MG = 0x7B7B7B7B  ;
constexpr float MG_SCALE = 16.0f;
constexpr int CW_BAR = 4096;
constexpr int CW_DONE = 197632;
constexpr int CW_QHEAD = 196608;
constexpr int CW_PRB = 200000;
constexpr int CW_CNT = 131072;

constexpr int RING_BYTES = 131072, AUX_OFF = RING_BYTES, AUX_BYTES = 8192, MISC_OFF = AUX_OFF + AUX_BYTES;
constexpr int LDS_BYTES = 147456;
constexpr int NWAVES = 8, NTHR = 512;

#define GAS __attribute__((address_space(1)))
#define LAS __attribute__((address_space(3)))
typedef unsigned short bf16_t;
typedef unsigned u32x4 __attribute__((ext_vector_type(4)));
typedef unsigned u32x2 __attribute__((ext_vector_type(2)));
typedef float f32x4 __attribute__((ext_vector_type(4)));
typedef float f32x2 __attribute__((ext_vector_type(2)));
typedef short bf16x8 __attribute__((ext_vector_type(8)));
typedef short s16x4 __attribute__((ext_vector_type(4)));
typedef float f32x16 __attribute__((ext_vector_type(16)));

__device__ __forceinline__ unsigned cvt_pk_bf16(float lo, float hi) { unsigned r; asm volatile("v_cvt_pk_bf16_f32 %0, %1, %2" : "=v"(r) : "v"(lo), "v"(hi)); return r; }
__device__ __forceinline__ float bf2f(unsigned short b) { return __uint_as_float(((unsigned)b) << 16); }
__device__ __forceinline__ float bflo(unsigned w) { return __uint_as_float(w << 16); }
__device__ __forceinline__ float bfhi(unsigned w) { return __uint_as_float(w & 0xffff0000u); }
__device__ __forceinline__ unsigned short f2bf(float f) { return (unsigned short)(cvt_pk_bf16(f, 0.f) & 0xffffu); }
typedef int i32x4 __attribute__((ext_vector_type(4)));
typedef int i32x8 __attribute__((ext_vector_type(8)));
__device__ __forceinline__ float clamp448(float x) { return __builtin_amdgcn_fmed3f(x, -448.f, 448.f); }
__device__ __forceinline__ unsigned pk_fp8x4(const f32x4 v) {
    int w = 0;
    w = __builtin_amdgcn_cvt_pk_fp8_f32(clamp448(v.x), clamp448(v.y), w, false);
    w = __builtin_amdgcn_cvt_pk_fp8_f32(clamp448(v.z), clamp448(v.w), w, true);
    return (unsigned)w;
}
__device__ __forceinline__ unsigned pk_fp8x4_nc(float a, float b, float c, float d) {
    int w = 0; w = __builtin_amdgcn_cvt_pk_fp8_f32(a, b, w, false); w = __builtin_amdgcn_cvt_pk_fp8_f32(c, d, w, true); return (unsigned)w; }
__device__ __forceinline__ int lane4_fresh() { int l; asm volatile("v_mbcnt_lo_u32_b32 %0, -1, 0\n\tv_mbcnt_hi_u32_b32 %0, -1, %0\n\tv_lshlrev_b32 %0, 2, %0" : "=v"(l)); return l; }
__device__ __forceinline__ float shx(float v, int o, int l4) { return __int_as_float(__builtin_amdgcn_ds_bpermute(l4 ^ (o << 2), __float_as_int(v))); }
__device__ __forceinline__ float wave_sum(float v) {
    const int l4 = lane4_fresh();
#pragma unroll
    for (int o = 1; o < 64; o <<= 1) v += shx(v, o, l4);
    return v;
}
__device__ __forceinline__ int ltid() { int t = threadIdx.x; asm volatile("" : "+v"(t)); return t; }
__device__ __forceinline__ float sigmoidf_(float x) { return __builtin_amdgcn_rcpf(1.0f + __builtin_amdgcn_exp2f(-1.4426950408889634f * x)); }

#define XB_TMO      128
#define XB_XCNT(j)  (256  + 64 * (j))
#define XB_XSUB(j)  (1280 + 64 * (j))
#define XB_XGEN(j)  (2304 + 64 * (j))
#define XB_TOP      3328
#define XB_TOPGEN   3392
#define XCD_BAR_WORDS 3456
#define XB_SPIN_CAP (1u << 18)

__device__ __forceinline__ unsigned xb_ld(unsigned* p)              { return __hip_atomic_load(p, __ATOMIC_RELAXED, __HIP_MEMORY_SCOPE_AGENT); }
__device__ __forceinline__ unsigned xb_add(unsigned* p, unsigned v) { return __hip_atomic_fetch_add(p, v, __ATOMIC_RELAXED, __HIP_MEMORY_SCOPE_AGENT); }
__device__ __forceinline__ unsigned xb_xcc_id() { return (unsigned)__builtin_amdgcn_s_getreg((3 << 11) | 20) & 0xFu; }
#define XB_SPIN(cond, bar) do { unsigned _sp = 0; while (cond) { __builtin_amdgcn_s_sleep(1); \
    if ((++_sp & 255u) == 0u) { if (xb_ld(&(bar)[XB_TMO])) break; if (_sp > XB_SPIN_CAP) { atomicAdd(&(bar)[XB_TMO], 1u); break; } } } } while (0)

struct XcdBarrier {
    unsigned* bar; unsigned x;
    volatile LAS unsigned* st;
};
__device__ __forceinline__ XcdBarrier xcd_barrier_post(unsigned* bar, volatile LAS unsigned* st) {
    XcdBarrier b; b.bar = bar; b.x = xb_xcc_id(); b.st = st;
    if (threadIdx.x == 0) (void)xb_add(&bar[XB_XCNT(b.x)], 1u);
    return b;
}
__device__ __forceinline__ void xcd_barrier_complete(unsigned* bar, unsigned x, unsigned& nloc, unsigned& nx) {
    const unsigned G = gridDim.x * gridDim.y * gridDim.z;
    unsigned sum, cnt, mine, sp = 0u;
    for (;;) {
        sum = 0u; cnt = 0u; mine = 0u;
#pragma unroll
        for (unsigned j = 0; j < 16; ++j) { const unsigned c = xb_ld(&bar[XB_XCNT(j)]); sum += c; cnt += (c > 0u) ? 1u : 0u; mine = (j == x) ? c : mine; }
        if (sum == G) break;
        __builtin_amdgcn_s_sleep(1);
        if ((++sp & 255u) == 0u) { if (xb_ld(&bar[XB_TMO])) break; if (sp > XB_SPIN_CAP) { atomicAdd(&bar[XB_TMO], 1u); break; } }
    }
    nloc = mine > 0u ? mine : 1u; nx = cnt > 0u ? cnt : 1u;
}
__device__ __forceinline__ void xcd_barrier(const XcdBarrier& b) {
    asm volatile("s_waitcnt vmcnt(0)" ::: "memory");
    __syncthreads();
    if (threadIdx.x == 0) {
        unsigned* bar = b.bar;
        __builtin_amdgcn_s_waitcnt(0);
        unsigned nloc = b.st[0], nx = b.st[1];
        if (nloc == 0u) { xcd_barrier_complete(bar, b.x, nloc, nx); b.st[0] = nloc; b.st[1] = nx; }
        const unsigned old = xb_add(&bar[XB_XSUB(b.x)], 1u);
        const unsigned gen = old / nloc;
        if (old + 1u == (gen + 1u) * nloc) {
            __builtin_amdgcn_fence(__ATOMIC_RELEASE, "agent");
            asm volatile("s_waitcnt vmcnt(0)" ::: "memory");
            const unsigned og = xb_add(&bar[XB_TOP], 1u);
            const unsigned tg = og / nx;
            if (og + 1u == (tg + 1u) * nx) xb_add(&bar[XB_TOPGEN], 1u);
            else XB_SPIN(xb_ld(&bar[XB_TOPGEN]) == tg, bar);
            __builtin_amdgcn_fence(__ATOMIC_ACQUIRE, "agent");
            xb_add(&bar[XB_XGEN(b.x)], 1u);
            asm volatile("s_waitcnt vmcnt(0)" ::: "memory");
        } else {
            XB_SPIN(xb_ld(&bar[XB_XGEN(b.x)]) == gen, bar);
            __builtin_amdgcn_fence(__ATOMIC_ACQUIRE, "agent");
            asm volatile("s_waitcnt vmcnt(0)" ::: "memory");
        }
    }
    __syncthreads();
}

namespace pg8 {
constexpr int BM = 256, BK = 64, HALF = 128, HTB = HALF * BK * 2, STAGE_BYTES = 8 * HTB;
__device__ __forceinline__ int lds_byte(int r, int c) { const int st = (r >> 4) * 2 + (c >> 5), rr = r & 15, cc = c & 31, ob = rr * 64 + cc * 2; return st * 1024 + (ob ^ (((ob >> 9) & 1) << 5)); }
__device__ __forceinline__ void stage_rc(int b, int& R, int& C) { const int st = b / 1024, sb = b % 1024, swz = sb ^ (((sb >> 9) & 1) << 5); R = (st >> 1) * 16 + swz / 64; C = (st & 1) * 32 + (swz % 64) / 2; }
__device__ __forceinline__ int perm32(int rho) { const int n = rho >> 4, i = rho & 15; return 8 * (i >> 2) + 4 * n + (i & 3); }

struct Unit { int pm, pn, e, half; const char* a; const char* b; };
struct Gemm { int lda, ldb, K; int sw, sa; int kb; };

template <class Epi, class Sched, bool GATHER = false, bool F8 = false>
__device__ __forceinline__ void gemm_phase(LAS unsigned char* lds, const Gemm g, const Sched& S, const Epi& E) {
    int tid = threadIdx.x; asm volatile("" : "+v"(tid));
    const int wid = __builtin_amdgcn_readfirstlane(tid >> 6), lane = tid & 63, wr = wid >> 2, wc = wid & 3, fr = lane & 15, fq = lane >> 4;
    constexpr int ESZ = F8 ? 1 : 2;
    const int nt = g.K / (F8 ? 128 : BK);
    unsigned voffA[2], voffB[2]; int rowA[2];
#pragma unroll
    for (int i = 0; i < 2; ++i) { int R, C; stage_rc(tid * 16 + i * 8192, R, C); const int Rb = Epi::PERM ? ((R & ~31) + perm32(R & 31)) : R;
        voffA[i] = GATHER ? (unsigned)C * 2u : (unsigned)(R * g.lda * ESZ + C * 2); voffB[i] = (unsigned)(Rb * g.ldb * ESZ + C * 2); rowA[i] = R; }
    unsigned cv0[2] = {0u, 0u}, cv1[2] = {0u, 0u}, nv0[2] = {0u, 0u}, nv1[2] = {0u, 0u};
#define PG8_GOFF(u_, v0_, v1_) do { if constexpr (GATHER) { _Pragma("unroll") for (int _i = 0; _i < 2; ++_i) { \
        v0_[_i] = (unsigned)S.a_row(u_, rowA[_i]) * (unsigned)(g.lda * ESZ) + voffA[_i]; v1_[_i] = (unsigned)S.a_row(u_, rowA[_i] + HALF) * (unsigned)(g.lda * ESZ) + voffA[_i]; } } } while (0)
#define PG8_STAGE_A(bufoff, gbase, h, nx) do { if constexpr (GATHER) { unsigned va_[2]; va_[0] = (nx) ? ((h) ? nv1[0] : nv0[0]) : ((h) ? cv1[0] : cv0[0]); va_[1] = (nx) ? ((h) ? nv1[1] : nv0[1]) : ((h) ? cv1[1] : cv0[1]); \
        PG8_STAGE(bufoff, gbase, va_); } else { PG8_STAGE(bufoff, (gbase) + ((h) ? hstepA : (size_t)0), voffA); } } while (0)
    const size_t kstep = (size_t)(BK * 2), kstepB = g.kb ? (size_t)g.kb : kstep;
    const size_t hstepA = (size_t)HALF * g.lda * ESZ, hstepB = (size_t)HALF * g.ldb * ESZ;
    const unsigned ldsw = (unsigned)wid * 1024u;
    const int aoff = F8 ? lds_byte(wr * 64 + fr, fq * 16) + (fq & 1) * 16 : lds_byte(wr * 64 + fr, fq * 8), boff = F8 ? lds_byte(wc * 32 + fr, fq * 16) + (fq & 1) * 16 : lds_byte(wc * 32 + fr, fq * 8);
    const int aoff2 = aoff ^ 16, boff2 = boff ^ 16;
#define PG8_SA(b, h) (((b) * 2 + (h)) * HTB)
#define PG8_SB(b, h) ((4 + (b) * 2 + (h)) * HTB)
#define PG8_STAGE(bufoff, gbase, voff) do { _Pragma("unroll") for (int _i = 0; _i < 2; ++_i) \
        __builtin_amdgcn_global_load_lds((const unsigned*)((const char*)(gbase) + (voff)[_i]), (LAS unsigned*)(lds + (bufoff) + ldsw + _i * 8192), 16, 0, 0); } while (0)
#define PG8_LDA(dst, b, h) do { if constexpr (F8) { _Pragma("unroll") for (int m = 0; m < 4; ++m) dst##8[m] = PG8_CAT(*(const LAS i32x4*)(lds + PG8_SA(b, h) + aoff + m * 2048), *(const LAS i32x4*)(lds + PG8_SA(b, h) + aoff2 + m * 2048)); } else { \
        _Pragma("unroll") for (int m = 0; m < 4; ++m) _Pragma("unroll") for (int k = 0; k < 2; ++k) dst[m][k] = *(const LAS bf16x8*)(lds + PG8_SA(b, h) + aoff + m * 2048 + k * 1024); } } while (0)
#define PG8_LDB(dst, b, h) do { if constexpr (F8) { _Pragma("unroll") for (int n = 0; n < 2; ++n) dst##8[n] = PG8_CAT(*(const LAS i32x4*)(lds + PG8_SB(b, h) + boff + n * 2048), *(const LAS i32x4*)(lds + PG8_SB(b, h) + boff2 + n * 2048)); } else { \
        _Pragma("unroll") for (int n = 0; n < 2; ++n) _Pragma("unroll") for (int k = 0; k < 2; ++k) dst[n][k] = *(const LAS bf16x8*)(lds + PG8_SB(b, h) + boff + n * 2048 + k * 1024); } } while (0)
#define PG8_CAT(x0, x1) __builtin_shufflevector(__builtin_bit_cast(i32x4, x0), __builtin_bit_cast(i32x4, x1), 0, 1, 2, 3, 4, 5, 6, 7)
#define PG8_MMA(ai, bj, At, Bt) do { __builtin_amdgcn_s_setprio(1); if constexpr (F8) { _Pragma("unroll") for (int m = 0; m < 4; ++m) _Pragma("unroll") for (int n = 0; n < 2; ++n) \
        asm volatile("v_mfma_f32_16x16x128_f8f6f4 %0, %1, %2, %0" : "+v"(acc[ai][bj][m][n]) : "v"(Bt##8[n]), "v"(At##8[m])); } else { \
        _Pragma("unroll") for (int m = 0; m < 4; ++m) _Pragma("unroll") for (int n = 0; n < 2; ++n) _Pragma("unroll") for (int k = 0; k < 2; ++k) \
        acc[ai][bj][m][n] = __builtin_amdgcn_mfma_f32_16x16x32_bf16(Bt[n][k], At[m][k], acc[ai][bj][m][n], 0, 0, 0); } __builtin_amdgcn_s_setprio(0); } while (0)
#define PG8_WAIT_V(n) asm volatile("s_waitcnt vmcnt(" #n ")" ::: "memory")
#define PG8_WAIT_L(n) asm volatile("s_waitcnt lgkmcnt(" #n ")" ::: "memory")
#define PG8_BAR __builtin_amdgcn_s_barrier()
#define PG8_SCHED __builtin_amdgcn_sched_barrier(0)
    Unit cur, nxt; int ui = 0;
    if (!S.next(0, cur)) return;
    f32x4 acc[2][2][4][2];
#pragma unroll
    for (int a = 0; a < 2; ++a)
#pragma unroll
        for (int b = 0; b < 2; ++b)
#pragma unroll
            for (int m = 0; m < 4; ++m)
#pragma unroll
                for (int n = 0; n < 2; ++n) acc[a][b][m][n] = (f32x4){0.f, 0.f, 0.f, 0.f};
    bf16x8 At[4][2], B0[2][2], B1[2][2]; i32x8 At8[4], B08[2], B18[2];
    const float fs_ = F8 ? __uint_as_float((unsigned)((g.sw & 255) + (g.sa & 255) - 127) << 23) : 1.0f;
    const char* cA = cur.a; const char* cB = cur.b;
    PG8_GOFF(cur, cv0, cv1);
    PG8_STAGE(PG8_SB(0, 0), cB, voffB); PG8_STAGE_A(PG8_SA(0, 0), cA, 0, false); PG8_STAGE(PG8_SB(0, 1), cB + hstepB, voffB); PG8_STAGE_A(PG8_SA(0, 1), cA, 1, false);
    if (wr == 1) PG8_BAR;
    PG8_WAIT_V(4); PG8_BAR;
    PG8_STAGE(PG8_SB(1, 0), cB + kstepB, voffB); PG8_STAGE_A(PG8_SA(1, 0), cA + kstep, 0, false); PG8_STAGE(PG8_SB(1, 1), cB + hstepB + kstepB, voffB);
    PG8_WAIT_V(6); PG8_BAR;
    for (;;) {
        const bool has_next = S.next(ui + 1, nxt);
        const bool chalf = __builtin_amdgcn_readfirstlane(cur.half) != 0;
        const char* nA = has_next ? nxt.a : cA; const char* nB = has_next ? nxt.b : cB;
        if constexpr (GATHER) { if (has_next) PG8_GOFF(nxt, nv0, nv1); else { nv0[0] = cv0[0]; nv0[1] = cv0[1]; nv1[0] = cv1[0]; nv1[1] = cv1[1]; } }
#pragma nounroll
        for (int t = 0; t < nt; t += 2) {
            const bool last = (t == nt - 2);
            const char* a1 = cA + (size_t)(t + 1) * kstep;
            const char* a2 = last ? nA : cA + (size_t)(t + 2) * kstep; const char* b2 = last ? nB : cB + (size_t)(t + 2) * kstepB;
            const char* a3 = a2 + kstep; const char* b3 = b2 + kstepB;
            PG8_LDB(B0, 0, 0); PG8_SCHED; PG8_LDA(At, 0, 0); PG8_STAGE_A(PG8_SA(1, 1), a1, 1, false);
            PG8_WAIT_L(8); PG8_BAR; PG8_WAIT_L(0); PG8_MMA(0, 0, At, B0); PG8_BAR; PG8_SCHED;
            PG8_LDB(B1, 0, 1); PG8_STAGE(PG8_SB(0, 0), b2, voffB);
            PG8_BAR; PG8_WAIT_L(0); PG8_MMA(0, 1, At, B1); PG8_BAR;
            PG8_LDA(At, 0, 1); PG8_STAGE_A(PG8_SA(0, 0), a2, 0, last);
            PG8_BAR; PG8_WAIT_L(0); if (!chalf) PG8_MMA(1, 0, At, B0); PG8_BAR; PG8_SCHED;
            PG8_STAGE(PG8_SB(0, 1), b2 + hstepB, voffB);
            PG8_WAIT_V(6); PG8_BAR; if (!chalf) PG8_MMA(1, 1, At, B1); PG8_BAR;
            PG8_LDB(B0, 1, 0); PG8_SCHED; PG8_LDA(At, 1, 0); PG8_STAGE_A(PG8_SA(0, 1), a2, 1, last);
            PG8_WAIT_L(8); PG8_BAR; PG8_WAIT_L(0); PG8_MMA(0, 0, At, B0); PG8_BAR; PG8_SCHED;
            PG8_LDB(B1, 1, 1); PG8_STAGE(PG8_SB(1, 0), b3, voffB);
            PG8_BAR; PG8_WAIT_L(0); PG8_MMA(0, 1, At, B1); PG8_BAR;
            PG8_LDA(At, 1, 1); PG8_STAGE_A(PG8_SA(1, 0), a3, 0, last);
            PG8_BAR; PG8_WAIT_L(0); if (!chalf) PG8_MMA(1, 0, At, B0); PG8_BAR; PG8_SCHED;
            PG8_STAGE(PG8_SB(1, 1), b3 + hstepB, voffB);
            PG8_WAIT_V(6); PG8_BAR; if (!chalf) PG8_MMA(1, 1, At, B1); PG8_BAR;
        }
        if constexpr (F8) asm volatile("s_nop 15\n\ts_nop 15" ::: "memory");
        { float fsl_ = fs_; asm volatile("" : "+s"(fsl_));
          E(acc, cur, wr, wc, fr, fq, fsl_); }
        if (!has_next) break;
#pragma unroll
        for (int a = 0; a < 2; ++a)
#pragma unroll
            for (int b = 0; b < 2; ++b)
#pragma unroll
                for (int m = 0; m < 4; ++m)
#pragma unroll
                    for (int n = 0; n < 2; ++n) acc[a][b][m][n] = (f32x4){0.f, 0.f, 0.f, 0.f};
        if constexpr (F8) { _Pragma("unroll") for (int a = 0; a < 2; ++a) _Pragma("unroll") for (int b = 0; b < 2; ++b) _Pragma("unroll") for (int m = 0; m < 4; ++m) _Pragma("unroll") for (int n = 0; n < 2; ++n) asm volatile("" : "+v"(acc[a][b][m][n])); asm volatile("s_nop 7" ::: "memory"); }
        cur = nxt; cA = nA; cB = nB; ++ui;
        if constexpr (GATHER) { cv0[0] = nv0[0]; cv0[1] = nv0[1]; cv1[0] = nv1[0]; cv1[1] = nv1[1]; }
    }
    PG8_WAIT_V(0);
    if (wr == 0) PG8_BAR;
    PG8_BAR;
#undef PG8_SA
#undef PG8_SB
#undef PG8_STAGE
#undef PG8_STAGE_A
#undef PG8_GOFF
#undef PG8_LDA
#undef PG8_LDB
#undef PG8_MMA
#undef PG8_CAT
#undef PG8_WAIT_V
#undef PG8_WAIT_L
#undef PG8_BAR
#undef PG8_SCHED
}
}

#ifndef ATT_FIXED
#define ATT_FIXED 1
#endif
namespace att {
constexpr int QBLK = 32, KVBLK = 64;
constexpr float SCALE = 0.088388347648318440f;
constexpr float THR = 8.f;
constexpr int SHM_V = KVBLK * HD * 2, SHM_K = KVBLK * HD * 2, SHM_ATTN = 2 * SHM_V + 2 * SHM_K + NWAVES * 64 * 4;
#define KSWZ(row, colB) ((row) * 256 + ((colB) ^ (((row) & 7) << 4)))
#define SBAR() __builtin_amdgcn_sched_barrier(0)
__device__ __forceinline__ int crow(int r, int hi) { return (r & 3) + 8 * (r >> 2) + 4 * hi; }
__device__ __forceinline__ unsigned cvtpk(float lo, float hi) { unsigned r; asm volatile("v_cvt_pk_bf16_f32 %0, %1, %2" : "=v"(r) : "v"(lo), "v"(hi)); return r; }

__device__ __forceinline__ void apply_mask(f32x16& p0, f32x16& p1, int kp0, int qpos, int hi) {
#pragma unroll
    for (int r = 0; r < 16; ++r) {
        const int k0 = kp0 + (r & 3) + 8 * (r >> 2) + 4 * hi, k1 = k0 + 32;
        const bool v0 = ((unsigned)k0 < (unsigned)SEQ) && ((unsigned)(k0 - qpos + 128) <= 256u);
        const bool v1 = ((unsigned)k1 < (unsigned)SEQ) && ((unsigned)(k1 - qpos + 128) <= 256u);
        p0[r] = v0 ? p0[r] : -1e30f; p1[r] = v1 ? p1[r] : -1e30f;
    }
}
__device__ __forceinline__ void partialSM(f32x16& p0, f32x16& p1, float& m_reg, float& mn, float& alpha) {
    constexpr float C = SCALE * 1.4426950408889634f;
    float pmax = p0[0];
#pragma unroll
    for (int r = 1; r < 16; ++r) pmax = fmaxf(pmax, p0[r]);
#pragma unroll
    for (int r = 0; r < 16; ++r) pmax = fmaxf(pmax, p1[r]);
    { auto rr = __builtin_amdgcn_permlane32_swap(__float_as_uint(pmax), __float_as_uint(pmax), false, false);
      pmax = fmaxf(__uint_as_float(rr[0]), __uint_as_float(rr[1])); }
    if (__builtin_expect(__all(pmax - m_reg <= THR / SCALE), 1)) { mn = m_reg; alpha = 1.f; }
    else { mn = fmaxf(m_reg, pmax); alpha = __builtin_amdgcn_exp2f((m_reg - mn) * C); m_reg = mn; }
    float mnC = -mn * C;
#pragma unroll
    for (int r = 0; r < 16; ++r) p0[r] = fmaf(p0[r], C, mnC);
#pragma unroll
    for (int r = 0; r < 16; ++r) p1[r] = fmaf(p1[r], C, mnC);
#pragma unroll
    for (int r = 0; r < 16; ++r) p0[r] = __builtin_amdgcn_exp2f(p0[r]);
}
__device__ __forceinline__ void partialSM_fixed(f32x16& p0, f32x16& p1, float mnC) {
    constexpr float C = SCALE * 1.4426950408889634f;
#pragma unroll
    for (int r = 0; r < 16; ++r) p0[r] = fmaf(p0[r], C, mnC);
#pragma unroll
    for (int r = 0; r < 16; ++r) p1[r] = fmaf(p1[r], C, mnC);
#pragma unroll
    for (int r = 0; r < 16; ++r) p0[r] = __builtin_amdgcn_exp2f(p0[r]);
}
__device__ __forceinline__ void finishSM(f32x16& p0, f32x16& p1, float alpha, float& l_reg, bf16x8& pa0, bf16x8& pa1, bf16x8& pa2, bf16x8& pa3) {
#pragma unroll
    for (int r = 0; r < 16; ++r) p1[r] = __builtin_amdgcn_exp2f(p1[r]);
    float ps = 0;
#pragma unroll
    for (int r = 0; r < 16; ++r) ps += p0[r];
#pragma unroll
    for (int r = 0; r < 16; ++r) ps += p1[r];
    { auto rr = __builtin_amdgcn_permlane32_swap(__float_as_uint(ps), __float_as_uint(ps), false, false);
      ps = __uint_as_float(rr[0]) + __uint_as_float(rr[1]); }
    l_reg = l_reg * alpha + ps;
#define PK4(P, BASE, OUT) do { unsigned a0 = cvtpk(P[BASE + 0], P[BASE + 1]), a1 = cvtpk(P[BASE + 2], P[BASE + 3]);   \
    unsigned b0 = cvtpk(P[BASE + 4], P[BASE + 5]), b1 = cvtpk(P[BASE + 6], P[BASE + 7]);                              \
    auto r0 = __builtin_amdgcn_permlane32_swap(a0, b0, false, false); auto r1 = __builtin_amdgcn_permlane32_swap(a1, b1, false, false); \
    u32x4 w = {r0[0], r1[0], r0[1], r1[1]}; OUT = *reinterpret_cast<bf16x8*>(&w); } while (0)
    PK4(p0, 0, pa0); PK4(p0, 8, pa1); PK4(p1, 0, pa2); PK4(p1, 8, pa3);
#undef PK4
}
__device__ __forceinline__ void qkt(f32x16& p0, f32x16& p1, const bf16_t* Ks, const bf16x8* qr, int r32, int hi) {
    p0 = f32x16{}; p1 = f32x16{};
#pragma unroll
    for (int d0 = 0; d0 < 8; ++d0) { int cb = (d0 * 16 + hi * 8) * 2;
        bf16x8 b0 = *reinterpret_cast<const bf16x8*>((const char*)Ks + KSWZ(r32, cb));
        bf16x8 b1 = *reinterpret_cast<const bf16x8*>((const char*)Ks + KSWZ(32 + r32, cb));
        p0 = __builtin_amdgcn_mfma_f32_32x32x16_bf16(b0, qr[d0], p0, 0, 0, 0);
        p1 = __builtin_amdgcn_mfma_f32_32x32x16_bf16(b1, qr[d0], p1, 0, 0, 0); }
}
__device__ __forceinline__ int v_st(int k, int c) { const int kk = (k & ~0xC) | ((k & 4) << 1) | ((k & 8) >> 1); return ((kk >> 3) * 4 + (c >> 5)) * 512 + ((kk & 7) * 32 + (c & 31)) * 2; }
__device__ __forceinline__ int v_rd_base(int lane) { return ((lane & 3) << 3) | (((lane >> 2) & 3) << 6) | (((lane >> 4) & 1) << 5) | (((lane >> 5) & 1) << 8); }
constexpr int v_rd_off(int d0, int ks, int half) { return d0 * 512 + ks * 4096 + half * 2048; }
template <int OFF> __device__ __forceinline__ s16x4 tr_read(int vb) {
    s16x4 r; asm volatile("ds_read_b64_tr_b16 %0, %1 offset:%2" : "=&v"(r) : "v"(vb), "i"(OFF) : "memory"); return r;
}
template <int D0> __device__ __forceinline__ void pv_one(f32x16& od, int vb, bf16x8 pa0, bf16x8 pa1, bf16x8 pa2, bf16x8 pa3) {
    const s16x4 l0 = tr_read<v_rd_off(D0, 0, 0)>(vb), h0 = tr_read<v_rd_off(D0, 0, 1)>(vb), l1 = tr_read<v_rd_off(D0, 1, 0)>(vb), h1 = tr_read<v_rd_off(D0, 1, 1)>(vb);
    const s16x4 l2 = tr_read<v_rd_off(D0, 2, 0)>(vb), h2 = tr_read<v_rd_off(D0, 2, 1)>(vb), l3 = tr_read<v_rd_off(D0, 3, 0)>(vb), h3 = tr_read<v_rd_off(D0, 3, 1)>(vb);
    asm volatile("s_waitcnt lgkmcnt(0)" ::: "memory"); SBAR();
#define PK(L, H) (bf16x8){L[0], L[1], L[2], L[3], H[0], H[1], H[2], H[3]}
    od = __builtin_amdgcn_mfma_f32_32x32x16_bf16(pa0, PK(l0, h0), od, 0, 0, 0);
    od = __builtin_amdgcn_mfma_f32_32x32x16_bf16(pa1, PK(l1, h1), od, 0, 0, 0);
    od = __builtin_amdgcn_mfma_f32_32x32x16_bf16(pa2, PK(l2, h2), od, 0, 0, 0);
    od = __builtin_amdgcn_mfma_f32_32x32x16_bf16(pa3, PK(l3, h3), od, 0, 0, 0);
#undef PK
}
__device__ __forceinline__ void pv_d0(f32x16* o, int vb, bf16x8 pa0, bf16x8 pa1, bf16x8 pa2, bf16x8 pa3) {
    pv_one<0>(o[0], vb, pa0, pa1, pa2, pa3); pv_one<1>(o[1], vb, pa0, pa1, pa2, pa3); pv_one<2>(o[2], vb, pa0, pa1, pa2, pa3); pv_one<3>(o[3], vb, pa0, pa1, pa2, pa3);
}

template <int MODE>
__device__ __forceinline__ void attn_body(const bf16_t* __restrict__ Qb, const bf16_t* __restrict__ Kh, const bf16_t* __restrict__ Vh,
                                          bf16_t* __restrict__ Ob, int NT, int nctx, int q0, float sink, char* lds) {
    constexpr int ldq = MIXW, ldk = 256, ldo = MIXW;
    int tid = threadIdx.x; asm volatile("" : "+v"(tid));
    const int wid = tid >> 6, lane = tid & 63, r32 = lane & 31, hi = lane >> 5;
    bf16_t* V_lds = (bf16_t*)lds; bf16_t* K_lds = (bf16_t*)(lds + 2 * SHM_V);
    float* ws = (float*)(lds + 2 * SHM_V + 2 * SHM_K) + wid * 64; float* li_l = ws; float* al_l = ws + 32;
    float m_reg = (MODE == 0 && ATT_FIXED) ? sink : -1e30f, l_reg = 0; f32x16 o[4] = {}; bf16x8 qr[8];
    const float mnCf = -m_reg * (SCALE * 1.4426950408889634f);
    const bf16_t* Qw = Qb + (long)(wid * QBLK + r32) * ldq + hi * 8;
#pragma unroll
    for (int d0 = 0; d0 < 8; ++d0) qr[d0] = *reinterpret_cast<const bf16x8*>(Qw + d0 * 16);
    const int sr = tid >> 4, sc = (tid & 15) * 8, vst0 = v_st(sr, sc), vst1 = v_st(32 + sr, sc);
    const int vb0 = (int)(uintptr_t)V_lds + v_rd_base(lane);
    const int qpos = q0 + wid * QBLK + r32;
    const int bandT0 = CTX + q0 - 128;
    struct { bf16x8 vs0, vs1, ks0, ks1; } sr_[2];
#define TROW(jt) ((MODE == 0 || (jt) < nctx) ? (jt) * KVBLK : bandT0 + ((jt) - nctx) * KVBLK)
#define SLOAD(i, jt) do { int ra_ = TROW(jt) + sr, rb_ = ra_ + 32; if (MODE == 1) { ra_ = ra_ < TOK - 1 ? ra_ : TOK - 1; rb_ = rb_ < TOK - 1 ? rb_ : TOK - 1; } \
    sr_[i].vs0 = *reinterpret_cast<const bf16x8*>(&Vh[(long)ra_ * ldk + sc]); sr_[i].vs1 = *reinterpret_cast<const bf16x8*>(&Vh[(long)rb_ * ldk + sc]); \
    sr_[i].ks0 = *reinterpret_cast<const bf16x8*>(&Kh[(long)ra_ * ldk + sc]); sr_[i].ks1 = *reinterpret_cast<const bf16x8*>(&Kh[(long)rb_ * ldk + sc]); } while (0)
#define SWRITE(b, i) do { *(bf16x8*)((char*)V_lds + (b) * SHM_V + vst0) = sr_[i].vs0;          \
    *(bf16x8*)((char*)V_lds + (b) * SHM_V + vst1) = sr_[i].vs1; int kc = sc * 2;               \
    *(bf16x8*)((char*)K_lds + (b) * SHM_K + KSWZ(sr, kc)) = sr_[i].ks0;                       \
    *(bf16x8*)((char*)K_lds + (b) * SHM_K + KSWZ(32 + sr, kc)) = sr_[i].ks1; } while (0)
#define SWAIT() asm volatile("s_waitcnt vmcnt(4)" ::: "memory")
#define RESC(a) do { if (__any((a) < 1.f)) { if (hi == 0) al_l[r32] = (a); asm volatile("s_waitcnt lgkmcnt(0)" ::: "memory"); \
    _Pragma("unroll") for (int d = 0; d < 4; ++d) _Pragma("unroll") for (int r = 0; r < 16; ++r) o[d][r] *= al_l[crow(r, hi)]; } } while (0)
#define MASK(PA, PB, jt) do { if (MODE == 1 && (jt) >= nctx) apply_mask(PA, PB, q0 - 128 + ((jt) - nctx) * KVBLK, qpos, hi); } while (0)
#define PSM(PA, PB, mn_, al_) do { if (MODE == 0 && ATT_FIXED) { partialSM_fixed(PA, PB, mnCf); al_ = 1.f; } else partialSM(PA, PB, m_reg, mn_, al_); } while (0)
#define RESCM(a) do { if (MODE == 1 || !ATT_FIXED) RESC(a); } while (0)
    f32x16 pA0, pA1, pB0, pB1; float mnA, mnB, alA, alB; bf16x8 pa0, pa1, pa2, pa3;
    constexpr int SE = 0, SO = 1;
    SLOAD(SE, 0); asm volatile("s_waitcnt vmcnt(0)" ::: "memory"); SWRITE(0, SE); __syncthreads();
    qkt(pA0, pA1, K_lds, qr, r32, hi); MASK(pA0, pA1, 0); PSM(pA0, pA1, mnA, alA);
    SLOAD(SO, 1); if (2 < NT) SLOAD(SE, 2);
    SWAIT(); SWRITE(1, SO); __syncthreads();
    for (int j = 1; j + 1 < NT; j += 2) {
        SBAR(); qkt(pB0, pB1, (bf16_t*)((char*)K_lds + SHM_K), qr, r32, hi);
        finishSM(pA0, pA1, alA, l_reg, pa0, pa1, pa2, pa3); SBAR();
        SLOAD(SO, j + 2); SBAR();
        pv_d0(o, vb0, pa0, pa1, pa2, pa3); MASK(pB0, pB1, j); PSM(pB0, pB1, mnB, alB);
        __syncthreads(); SWAIT(); SWRITE(0, SE);
        RESCM(alB); __syncthreads();
        SBAR(); qkt(pA0, pA1, K_lds, qr, r32, hi);
        finishSM(pB0, pB1, alB, l_reg, pa0, pa1, pa2, pa3); SBAR();
        if (j + 3 < NT) SLOAD(SE, j + 3); SBAR();
        pv_d0(o, vb0 + (int)SHM_V, pa0, pa1, pa2, pa3); MASK(pA0, pA1, j + 1); PSM(pA0, pA1, mnA, alA);
        __syncthreads(); SWAIT(); SWRITE(1, SO);
        RESCM(alA); __syncthreads();
    }
    SBAR(); qkt(pB0, pB1, (bf16_t*)((char*)K_lds + SHM_K), qr, r32, hi);
    finishSM(pA0, pA1, alA, l_reg, pa0, pa1, pa2, pa3); SBAR();
    pv_d0(o, vb0, pa0, pa1, pa2, pa3); MASK(pB0, pB1, NT - 1); PSM(pB0, pB1, mnB, alB);
    __syncthreads(); RESCM(alB);
    finishSM(pB0, pB1, alB, l_reg, pa0, pa1, pa2, pa3); SBAR();
    pv_d0(o, vb0 + (int)SHM_V, pa0, pa1, pa2, pa3);
    if (MODE == 1) l_reg += __builtin_amdgcn_exp2f(sink * 1.4426950408889634f - m_reg * (SCALE * 1.4426950408889634f));
    if (hi == 0) li_l[r32] = l_reg; asm volatile("s_waitcnt lgkmcnt(0)" ::: "memory");
    float rli[16];
#pragma unroll
    for (int r = 0; r < 16; ++r) rli[r] = __builtin_amdgcn_rcpf(li_l[crow(r, hi)]);
    bf16_t* Ow = Ob + (long)(wid * QBLK) * ldo;
#pragma unroll
    for (int r = 0; r < 16; ++r) { int orow = crow(r, hi);
#pragma unroll
        for (int d0 = 0; d0 < 4; ++d0) Ow[(long)orow * ldo + d0 * 32 + r32] = f2bf(o[d0][r] * rli[r]); }
    asm volatile("s_waitcnt vmcnt(0) lgkmcnt(0)" ::: "memory");
    __syncthreads();
#undef TROW
#undef SLOAD
#undef SWRITE
#undef SWAIT
#undef RESC
#undef MASK
#undef PSM
#undef RESCM
}
}


namespace att8 {
constexpr int KVBLK = 64, QBLK = 32;
constexpr float SCALE = att::SCALE, THR8 = 1.5f, PSCALE = 64.f;
constexpr int E_ONE = 0x7F7F7F7F, E_P = 0x79797979;
constexpr int SHM8_K = 8192, SHM8_V = 8192;
__device__ __forceinline__ void mfma8(f32x16& acc, const i32x8& a, const i32x8& b, int sa, int sb) {
    asm volatile("v_mfma_scale_f32_32x32x64_f8f6f4 %0, %1, %2, %0, %3, %4 op_sel_hi:[0,0,0]" : "+v"(acc) : "v"(a), "v"(b), "v"(sa), "v"(sb)); }
__device__ __forceinline__ void mfma8_pre(f32x16& acc, const i32x8& a, const i32x8& b, int sa, int sb) {
    asm volatile("s_nop 3\n\tv_mfma_scale_f32_32x32x64_f8f6f4 %0, %1, %2, %0, %3, %4 op_sel_hi:[0,0,0]" : "+v"(acc) : "v"(a), "v"(b), "v"(sa), "v"(sb)); }
__device__ __forceinline__ void mfma8_post(f32x16& acc, const i32x8& a, const i32x8& b, int sa, int sb) {
    asm volatile("v_mfma_scale_f32_32x32x64_f8f6f4 %0, %1, %2, %0, %3, %4 op_sel_hi:[0,0,0]\n\ts_nop 15\n\ts_nop 7" : "+v"(acc) : "v"(a), "v"(b), "v"(sa), "v"(sb)); }
__device__ __forceinline__ i32x8 ld32(const char* p0, const char* p1) { const i32x4 lo = *(const i32x4*)p0, hi = *(const i32x4*)p1; return __builtin_shufflevector(lo, hi, 0, 1, 2, 3, 4, 5, 6, 7); }
__device__ __forceinline__ int koff(int key, int chunk) { return key * 128 + ((chunk ^ ((key >> 1) & 7)) << 4); }
__device__ __forceinline__ int voff(int n, int chunk) { return n * 64 + ((chunk ^ ((n >> 2) & 3)) << 4); }
__device__ __forceinline__ void qkt8(f32x16& p0, f32x16& p1, const char* Ks, const i32x8 (&qr)[2], int r32, int hi, int one, float off) {
#pragma unroll
    for (int r = 0; r < 16; ++r) { p0[r] = off; p1[r] = off; }
    const i32x8 a00 = ld32(Ks + koff(r32, 2 * hi), Ks + koff(r32, 2 * hi + 1)), a10 = ld32(Ks + koff(32 + r32, 2 * hi), Ks + koff(32 + r32, 2 * hi + 1));
    const i32x8 a01 = ld32(Ks + koff(r32, 4 + 2 * hi), Ks + koff(r32, 5 + 2 * hi)), a11 = ld32(Ks + koff(32 + r32, 4 + 2 * hi), Ks + koff(32 + r32, 5 + 2 * hi));
    mfma8_pre(p0, a00, qr[0], one, one); mfma8(p1, a10, qr[0], one, one);
    mfma8(p0, a01, qr[1], one, one); mfma8_post(p1, a11, qr[1], one, one);
}
template <bool FIRST>
__device__ __forceinline__ void partialSM8(f32x16& p0, f32x16& p1, float& off, float& alpha) {
    float pmax = p0[0];
#pragma unroll
    for (int r = 1; r < 16; ++r) pmax = fmaxf(pmax, p0[r]);
#pragma unroll
    for (int r = 0; r < 16; ++r) pmax = fmaxf(pmax, p1[r]);
    { auto rr = __builtin_amdgcn_permlane32_swap(__float_as_uint(pmax), __float_as_uint(pmax), false, false);
      pmax = fmaxf(__uint_as_float(rr[0]), __uint_as_float(rr[1])); }
    alpha = 1.f;
    if (FIRST || !__builtin_expect(__all(pmax <= 6.0f + THR8 * 1.4426950408889634f), 1)) {
        const float d = FIRST ? (pmax - 6.0f) : fmaxf(pmax - 6.0f, 0.f);
#pragma unroll
        for (int r = 0; r < 16; ++r) { p0[r] -= d; p1[r] -= d; }
        off -= d; if (!FIRST) alpha = __builtin_amdgcn_exp2f(-d);
    }
#pragma unroll
    for (int r = 0; r < 16; ++r) p0[r] = __builtin_amdgcn_exp2f(p0[r]);
}
__device__ __forceinline__ void finishSM8(f32x16& p0, f32x16& p1, float alpha, float& l_reg, i32x8& pa) {
#pragma unroll
    for (int r = 0; r < 16; ++r) p1[r] = __builtin_amdgcn_exp2f(p1[r]);
    float ps = 0;
#pragma unroll
    for (int r = 0; r < 16; ++r) ps += p0[r];
#pragma unroll
    for (int r = 0; r < 16; ++r) ps += p1[r];
    { auto rr = __builtin_amdgcn_permlane32_swap(__float_as_uint(ps), __float_as_uint(ps), false, false);
      ps = __uint_as_float(rr[0]) + __uint_as_float(rr[1]); }
    l_reg = l_reg * alpha + ps;
#pragma unroll
    for (int t = 0; t < 4; ++t) {
        pa[t] = (int)pk_fp8x4_nc(p0[4 * t], p0[4 * t + 1], p0[4 * t + 2], p0[4 * t + 3]);
        pa[4 + t] = (int)pk_fp8x4_nc(p1[4 * t], p1[4 * t + 1], p1[4 * t + 2], p1[4 * t + 3]); }
}
__device__ __forceinline__ void pv8(f32x16* o, const char* Vs, const i32x8& pa, int r32, int hi, int ep, int one) {
    const i32x8 b0 = ld32(Vs + voff(r32, 2 * hi), Vs + voff(r32, 2 * hi + 1)), b1 = ld32(Vs + voff(32 + r32, 2 * hi), Vs + voff(32 + r32, 2 * hi + 1));
    const i32x8 b2 = ld32(Vs + voff(64 + r32, 2 * hi), Vs + voff(64 + r32, 2 * hi + 1)), b3 = ld32(Vs + voff(96 + r32, 2 * hi), Vs + voff(96 + r32, 2 * hi + 1));
    mfma8_pre(o[0], pa, b0, ep, one); mfma8(o[1], pa, b1, ep, one); mfma8(o[2], pa, b2, ep, one); mfma8(o[3], pa, b3, ep, one);
}
constexpr float CREF = 104.5f, CHI = 104.5f + 8.0f * THR8 * 1.4426950408889634f, COFF0 = 56.5f;
__device__ __forceinline__ void mfma8u(f32x16& acc, const i32x8& a, const i32x8& b) { asm volatile("v_mfma_f32_32x32x64_f8f6f4 %0, %1, %2, %0" : "+v"(acc) : "v"(a), "v"(b)); }
__device__ __forceinline__ void mfma8u_pre(f32x16& acc, const i32x8& a, const i32x8& b) { asm volatile("s_nop 3\n\tv_mfma_f32_32x32x64_f8f6f4 %0, %1, %2, %0" : "+v"(acc) : "v"(a), "v"(b)); }
__device__ __forceinline__ void mfma8u_post(f32x16& acc, const i32x8& a, const i32x8& b) { asm volatile("v_mfma_f32_32x32x64_f8f6f4 %0, %1, %2, %0\n\ts_nop 15\n\ts_nop 7" : "+v"(acc) : "v"(a), "v"(b)); }
__device__ __forceinline__ void mfma8u_c(f32x16& d, const i32x8& a, const i32x8& b, const f32x16& c) { asm volatile("v_mfma_f32_32x32x64_f8f6f4 %0, %1, %2, %3" : "=&v"(d) : "v"(a), "v"(b), "v"(c)); }
__device__ __forceinline__ void qkt8c(f32x16& p0, f32x16& p1, const char* Ks, const i32x8 (&qr)[2], int r32, int hi, const f32x16& offv) {
    const i32x8 a00 = ld32(Ks + koff(r32, 2 * hi), Ks + koff(r32, 2 * hi + 1)), a10 = ld32(Ks + koff(32 + r32, 2 * hi), Ks + koff(32 + r32, 2 * hi + 1));
    const i32x8 a01 = ld32(Ks + koff(r32, 4 + 2 * hi), Ks + koff(r32, 5 + 2 * hi)), a11 = ld32(Ks + koff(32 + r32, 4 + 2 * hi), Ks + koff(32 + r32, 5 + 2 * hi));
    mfma8u_c(p0, a00, qr[0], offv); mfma8u_c(p1, a10, qr[0], offv);
    mfma8u(p0, a01, qr[1]); mfma8u_post(p1, a11, qr[1]);
}
template <bool FIRST>
__device__ __forceinline__ void smx8(f32x16& p0, f32x16& p1, float& offc, f32x16& offv, float& alpha, i32x8& pa) {
    float pmax = p0[0];
#pragma unroll
    for (int r = 1; r < 16; ++r) pmax = fmaxf(pmax, p0[r]);
#pragma unroll
    for (int r = 0; r < 16; ++r) pmax = fmaxf(pmax, p1[r]);
    { auto rr = __builtin_amdgcn_permlane32_swap(__float_as_uint(pmax), __float_as_uint(pmax), false, false);
      pmax = fmaxf(__uint_as_float(rr[0]), __uint_as_float(rr[1])); }
    alpha = 1.f;
    if (FIRST || !__builtin_expect(__all(pmax <= CHI), 1)) {
        const float d = FIRST ? (pmax - CREF) : fmaxf(pmax - CREF, 0.f);
#pragma unroll
        for (int r = 0; r < 16; ++r) { p0[r] -= d; p1[r] -= d; }
        offc -= d; if (!FIRST) alpha = __builtin_amdgcn_exp2f(-0.125f * d);
#pragma unroll
        for (int r = 0; r < 16; ++r) offv[r] = offc;
        asm volatile("s_nop 1" : "+v"(offv));
    }
#pragma unroll
    for (int t = 0; t < 4; ++t) {
        unsigned w0 = 0u, w1 = 0u;
#pragma unroll
        for (int b = 0; b < 4; ++b) { w0 = __builtin_amdgcn_cvt_pk_u8_f32(p0[4 * t + b], b, w0); w1 = __builtin_amdgcn_cvt_pk_u8_f32(p1[4 * t + b], b, w1); }
        pa[t] = (int)w0; pa[4 + t] = (int)w1; }
}
__device__ __forceinline__ void pv8c(f32x16* o, const char* Vs, const i32x8& pa, const i32x8& ones, int r32, int hi) {
    const i32x8 b0 = ld32(Vs + voff(r32, 2 * hi), Vs + voff(r32, 2 * hi + 1)), b1 = ld32(Vs + voff(32 + r32, 2 * hi), Vs + voff(32 + r32, 2 * hi + 1));
    const i32x8 b2 = ld32(Vs + voff(64 + r32, 2 * hi), Vs + voff(64 + r32, 2 * hi + 1)), b3 = ld32(Vs + voff(96 + r32, 2 * hi), Vs + voff(96 + r32, 2 * hi + 1));
    mfma8u_pre(o[0], pa, b0); mfma8u(o[1], pa, b1); mfma8u(o[2], pa, b2); mfma8u(o[3], pa, b3); mfma8u(o[4], pa, ones);
}
template <int MODE>
__device__ __forceinline__ void attn8_body(const unsigned char* __restrict__ Q8, const unsigned char* __restrict__ K8, const unsigned char* __restrict__ Vt,
                                           unsigned char* __restrict__ Ob, int NT, int nctx, int q0, float sink, char* lds) {
    int tid = threadIdx.x; asm volatile("" : "+v"(tid));
    const int wid = tid >> 6, lane = tid & 63, r32 = lane & 31, hi = lane >> 5;
    char* V_lds = lds; char* K_lds = lds + 2 * SHM8_V;
    float* ws = (float*)(lds + 2 * SHM8_V + 2 * SHM8_K) + wid * 64; float* li_l = ws; float* al_l = ws + 32;
    float offc = COFF0 + 2048.0f; f32x16 o[5] = {}; f32x16 offv;
#pragma unroll
    for (int r = 0; r < 16; ++r) offv[r] = offc;
    asm volatile("s_nop 1" : "+v"(offv));
    i32x8 qr[2];
    { const unsigned char* Qw = Q8 + (size_t)(wid * QBLK + r32) * MIXW + hi * 32;
      qr[0] = ld32((const char*)Qw, (const char*)Qw + 16); qr[1] = ld32((const char*)Qw + 64, (const char*)Qw + 80); }
    const int krow = tid >> 3, kch = tid & 7, kst = krow * 128 + ((kch ^ ((krow >> 1) & 7)) << 4);
    const int qpos = q0 + wid * QBLK + r32;
    const int bandX0 = (CTX + q0 - 128) / KVBLK;
    struct { u32x4 ks, vs; } sr_[2];
#define TIX(jt) ((MODE == 0 || (jt) < nctx) ? (jt) : (bandX0 + ((jt) - nctx) < TOK / KVBLK ? bandX0 + ((jt) - nctx) : TOK / KVBLK - 1))
#define SLOAD(i, jt) do { const int tx_ = TIX(jt); sr_[i].ks = *(const u32x4*)(K8 + (size_t)(tx_ * KVBLK + krow) * 256 + kch * 16); sr_[i].vs = *(const u32x4*)(Vt + (size_t)tx_ * 16384 + tid * 16); } while (0)
#define SWRITE(b, i) do { *(u32x4*)(K_lds + (b) * SHM8_K + kst) = sr_[i].ks; *(u32x4*)(V_lds + (b) * SHM8_V + tid * 16) = sr_[i].vs; } while (0)
#define RESC(a) do { if (__any((a) < 1.f)) { if (hi == 0) al_l[r32] = (a); asm volatile("s_waitcnt lgkmcnt(0)" ::: "memory"); \
    _Pragma("unroll") for (int r = 0; r < 16; ++r) { const float av_ = al_l[att::crow(r, hi)]; _Pragma("unroll") for (int d = 0; d < 5; ++d) o[d][r] *= av_; SBAR(); } } } while (0)
#define MASK(PA, PB, jt) do { if (MODE == 1 && (jt) >= nctx) att::apply_mask(PA, PB, q0 - 128 + ((jt) - nctx) * KVBLK, qpos, hi); } while (0)
#define STEP(t_, FIRST_, b_, set_) do { \
        SBAR(); qkt8c(p0, p1, K_lds + (b_) * SHM8_K, qr, r32, hi, offv); SBAR(); \
        if ((t_) + 1 < NT) { SWRITE(1 - (b_), set_); if ((t_) + 3 < NT) SLOAD(set_, (t_) + 3); } SBAR(); \
        MASK(p0, p1, t_); smx8<FIRST_>(p0, p1, offc, offv, al, pa); if (!(FIRST_)) RESC(al); SBAR(); \
        pv8c(o, V_lds + (b_) * SHM8_V, pa, ones, r32, hi); SBAR(); \
        __syncthreads(); } while (0)
    f32x16 p0, p1; float al; i32x8 pa;
    i32x8 ones; { int w1 = 0x38383838; ones = (i32x8){w1, w1, w1, w1, w1, w1, w1, w1}; asm volatile("" : "+v"(ones)); }
    SLOAD(0, 0); asm volatile("s_waitcnt vmcnt(0)" ::: "memory"); SWRITE(0, 0); SLOAD(1, 1); SLOAD(0, 2); __syncthreads();
    for (int t = 0; t < NT; t += 2) { STEP(t, false, 0, 1); STEP(t + 1, false, 1, 0); }
    asm volatile("s_nop 15\n\ts_nop 15" : "+v"(o[0]), "+v"(o[1]), "+v"(o[2]), "+v"(o[3]), "+v"(o[4]));
    if (MODE == 1) { if (hi == 0) li_l[r32] = __builtin_amdgcn_exp2f(sink * 1.4426950408889634f + 0.125f * (offc - COFF0)); asm volatile("s_waitcnt lgkmcnt(0)" ::: "memory"); }
    unsigned char* Ow = Ob + (long)(wid * QBLK) * MIXW;
#pragma unroll
    for (int r = 0; r < 16; ++r) { int orow = att::crow(r, hi);
        const float rl = W8_SCALE * __builtin_amdgcn_rcpf(MODE == 1 ? o[4][r] + li_l[orow] : o[4][r]);
        const unsigned w = pk_fp8x4((f32x4){o[0][r], o[1][r], o[2][r], o[3][r]} * rl);
#pragma unroll
        for (int d0 = 0; d0 < 4; ++d0) Ow[(long)orow * MIXW + d0 * 32 + r32] = (unsigned char)(w >> (8 * d0)); }
    asm volatile("s_waitcnt vmcnt(0) lgkmcnt(0)" ::: "memory");
    __syncthreads();
#undef STEP
#undef TIX
#undef SLOAD
#undef SWRITE
#undef RESC
#undef MASK
}
}

struct Args { const float* in[22]; float* out; unsigned char* ws; int ph_lo, ph_hi, li, pad; };
typedef const __attribute__((address_space(4))) Args* KArgs;
enum { I_X = 0, I_C, I_CTX, I_CCTX, I_WADA, I_BADA, I_N1G, I_N2G, I_WIN, I_POOLW, I_POOLS, I_QNG, I_KNG, I_SINK, I_WBR, I_WOUT, I_RW, I_RB, I_WG, I_WU, I_WD, I_FG };

__device__ __forceinline__ void ada_item(KArgs A, char* lds, int item) {
    const int tid = ltid(), wave = tid >> 6, lane = tid & 63;
    float* sil = (float*)lds;
    float* red = (float*)(lds + 16384);
    const float* cvec = A->in[I_C]; const float* ccvec = A->in[I_CCTX];
    for (int i = tid; i < DM; i += NTHR) { const float a = cvec[i], b = ccvec[i]; sil[i] = a * sigmoidf_(a); sil[DM + i] = b * sigmoidf_(b); }
    __syncthreads();
    const int l = item / 48, chunk = item % 48, col0 = chunk * 256 + lane * 4;
    const float* W = A->in[I_WADA] + (size_t)l * DM * ADA;
    f32x4 a0 = {0.f, 0.f, 0.f, 0.f}, a1 = {0.f, 0.f, 0.f, 0.f};
    const int d0 = wave * 256;
    for (int d = d0; d < d0 + 256; d += 8) {
        f32x4 w[8];
#pragma unroll
        for (int u = 0; u < 8; ++u) w[u] = *(const f32x4*)(W + (size_t)(d + u) * ADA + col0);
#pragma unroll
        for (int u = 0; u < 8; ++u) { const float s0 = sil[d + u], s1 = sil[DM + d + u]; a0 += s0 * w[u]; a1 += s1 * w[u]; }
    }
    *(f32x4*)(red + (wave * 2 + 0) * 256 + lane * 4) = a0;
    *(f32x4*)(red + (wave * 2 + 1) * 256 + lane * 4) = a1;
    __syncthreads();
    if (tid < 512) {
        const int w = tid >> 8, c = tid & 255;
        float s = A->in[I_BADA][(size_t)l * ADA + chunk * 256 + c];
#pragma unroll
        for (int k = 0; k < 8; ++k) s += red[(k * 2 + w) * 256 + c];
        ((float*)(A->ws + WS_MOD))[(size_t)(l * 2 + w) * ADA + chunk * 256 + c] = s;
    }
    __syncthreads();
}

struct CvtTile { const float* src; bf16_t* dst; int sp, dp, f8; };
constexpr int DENSE_TILES_L = 1280 + 384 + 256 + 16, DENSE_TILES = 2 * DENSE_TILES_L;
constexpr int MOE_TILES_L = 3 * 4096, MOE_TILES = DENSE_TILES_L + 2 * MOE_TILES_L  , CVT_BATCH = 2;
__device__ __forceinline__ void cvt_decode_dense(KArgs A, int t, CvtTile& c) {
    c.f8 = 0;
    const int l = t / DENSE_TILES_L; int r = t % DENSE_TILES_L;
    unsigned char* ws = A->ws;
    if (r < 1280) { const int tk = r / 80, tn = r % 80;
        c.src = A->in[I_WIN] + (size_t)l * DM * INW + (size_t)(tk * 128) * INW + tn * 128; c.sp = INW;
        { c.dst = (bf16_t*)(ws + WS_WIN + ((size_t)l * INW + tn * 128) * DM * 2 + tk * 128); c.dp = DM * 2; c.f8 = 1; }
        return; }
    r -= 1280;
    if (r < 384) { const int n = r / 128, q = r % 128, tk = q / 16, tn = q % 16;
        c.src = A->in[I_WBR] + ((size_t)(l * 3 + n) * MIXW + tk * 128) * DM + tn * 128; c.sp = DM;
        { c.dst = (bf16_t*)(ws + WS_WBR + (size_t)(l * 3 + n) * DM * MIXW * 2 + (size_t)(tn * 128) * MIXW + tk * 128); c.dp = MIXW; c.f8 = 1; }
        return; }
    r -= 384;
    if (r < 256) { const int tk = r / 16, tn = r % 16;
        c.src = A->in[I_WOUT] + ((size_t)l * DM + tk * 128) * DM + tn * 128; c.sp = DM;
        c.dst = (bf16_t*)(ws + WS_WOUT + (size_t)l * DM * DM * 2 + (size_t)(tn * 128) * DM + tk * 128); c.dp = DM; c.f8 = 1; return; }
    r -= 256;
    { const int g = r / 4, q = r % 4, tk = q / 2, tn = q % 2;
        c.src = A->in[I_POOLW] + ((size_t)(l * 4 + g) * 256 + tk * 128) * 256 + tn * 128; c.sp = 256;
        c.dst = (bf16_t*)(ws + WS_POOL) + ((size_t)(l * 4 + g) * 256 + tn * 128) * 256 + tk * 128; c.dp = 256; }
}
__device__ __forceinline__ void cvt_decode_moe(KArgs A, int t_, CvtTile& c) {
    if (t_ < DENSE_TILES_L) { cvt_decode_dense(A, DENSE_TILES_L + t_, c); return; }
    const int t = t_ - DENSE_TILES_L;
    const int l = t / MOE_TILES_L; int r = t % MOE_TILES_L;
    unsigned char* ws = A->ws;
    if (r < 8192) { const int s = r / 4096, q = r % 4096, e = q / 128, qq = q % 128, tk = qq / 8, tn = qq % 8;
        c.src = A->in[s ? I_WU : I_WG] + ((size_t)(l * NEXP + e) * DM + tk * 128) * FFD + tn * 128; c.sp = FFD;
        c.dst = (bf16_t*)(ws + WS_WGU + ((size_t)(l * NEXP + e) * 2048 + 256 * tn + 128 * s) * DM + tk * 128); c.dp = DM; c.f8 = 1; return; }
    r -= 8192;
    { const int e = r / 128, q = r % 128, tk = q / 16, tn = q % 16;
        c.src = A->in[I_WD] + ((size_t)(l * NEXP + e) * FFD + tk * 128) * DM + tn * 128; c.sp = DM;
        c.dst = (bf16_t*)(ws + WS_WD + ((((size_t)(l * NEXP + e) * 8 + (tn >> 1)) * 8 + tk) * 256 + (tn & 1) * 128) * 128); c.dp = 128; c.f8 = 1; }
}
template <bool NT> __device__ __forceinline__ void cvt_load(const CvtTile& c, int tid, f32x4 (&v)[8]) {
    const int lr = tid >> 5, lc = (tid & 31) * 4;
#pragma unroll
    for (int i = 0; i < 8; ++i) { const f32x4* p = (const f32x4*)(c.src + (size_t)(lr + 16 * i) * c.sp + lc); v[i] = NT ? __builtin_nontemporal_load(p) : *p; }
}
__device__ __forceinline__ void cvt_stage1(int tid, char* lds, const f32x4 (&v)[8]) {
    float* L1 = (float*)lds; const int lr = tid >> 5, lc = (tid & 31) * 4;
#pragma unroll
    for (int i = 0; i < 8; ++i) *(f32x4*)(L1 + (lr + 16 * i) * 132 + lc) = v[i];
    __syncthreads();
}
template <bool NT> __device__ __forceinline__ void cvt_stage2(const CvtTile& c, int tid, char* lds) {
    float* L1 = (float*)lds; char* L2 = lds + 128 * 132 * 4;
    if (c.f8) {
        { const int n = tid & 127, kq = tid >> 7;
#pragma unroll
          for (int cc = 0; cc < 4; ++cc) { const int kc = kq * 4 + cc; const float* s = L1 + (8 * kc) * 132 + n;
              u32x2 o; o.x = pk_fp8x4((f32x4){s[0], s[132], s[2 * 132], s[3 * 132]} * W8_SCALE); o.y = pk_fp8x4((f32x4){s[4 * 132], s[5 * 132], s[6 * 132], s[7 * 132]} * W8_SCALE);
              *(u32x2*)(L2 + n * 144 + kc * 8) = o; } }
        __syncthreads();
        { const int ch = tid & 7; unsigned char* d8 = (unsigned char*)c.dst;
#pragma unroll
          for (int i = 0; i < 2; ++i) { const int n = (tid >> 3) + 64 * i; const u32x4 o = *(const u32x4*)(L2 + n * 144 + ch * 16);
              u32x4* p = (u32x4*)(d8 + (size_t)n * c.dp + 16 * ch); if (NT) __builtin_nontemporal_store(o, p); else *p = o; } }
        return;
    }
    { const int n = tid & 127, kq = tid >> 7;
#pragma unroll
      for (int cc = 0; cc < 4; ++cc) { const int kc = kq * 4 + cc; const float* s = L1 + (8 * kc) * 132 + n;
          u32x4 o; o.x = cvt_pk_bf16(s[0], s[132]); o.y = cvt_pk_bf16(s[2 * 132], s[3 * 132]); o.z = cvt_pk_bf16(s[4 * 132], s[5 * 132]); o.w = cvt_pk_bf16(s[6 * 132], s[7 * 132]);
          *(u32x4*)(L2 + n * 272 + kc * 16) = o; } }
    __syncthreads();
    { const int kc = tid & 15;
#pragma unroll
      for (int i = 0; i < 4; ++i) { const int n = (tid >> 4) + 32 * i; const u32x4 o = *(const u32x4*)(L2 + n * 272 + kc * 16);
          u32x4* p = (u32x4*)(c.dst + (size_t)n * c.dp + 8 * kc); if (NT) __builtin_nontemporal_store(o, p); else *p = o; } }
}
__device__ __forceinline__ void cvt_static_dense(KArgs A, char* lds) {
    const int tid = ltid(), b = blockIdx.x, G = gridDim.x;
    int t, step, tend;
    if (G == 256) { if (b < 96) { t = b * 3; step = 1; tend = t + 3; } else { t = 288 + (b - 96); step = 160; tend = DENSE_TILES_L; } }
    else { t = b; step = G; tend = DENSE_TILES_L; }
    CvtTile c0, c1; f32x4 v0[8], v1[8];
    bool h0 = t < tend, h1 = (t + step) < tend;
    if (h0) { cvt_decode_dense(A, t, c0); cvt_load<false>(c0, tid, v0); }
    if (h1) { cvt_decode_dense(A, t + step, c1); cvt_load<false>(c1, tid, v1); }
    while (h0) {
        cvt_stage1(tid, lds, v0);
        CvtTile n0; const bool g0 = (t + 2 * step) < tend;
        if (g0) { cvt_decode_dense(A, t + 2 * step, n0); cvt_load<false>(n0, tid, v0); }
        cvt_stage2<false>(c0, tid, lds);
        if (!h1) break;
        cvt_stage1(tid, lds, v1);
        CvtTile n1; const bool g1 = (t + 3 * step) < tend;
        if (g1) { cvt_decode_dense(A, t + 3 * step, n1); cvt_load<false>(n1, tid, v1); }
        cvt_stage2<false>(c1, tid, lds);
        c0 = n0; c1 = n1; h0 = g0; h1 = g1; t += 2 * step;
    }
    __syncthreads();
}
__device__ __forceinline__ void cvt_queue(KArgs A, char* lds, int limit, int quota, unsigned* done, unsigned need) {
    const int tid = ltid();
    volatile int* qs = (volatile int*)(lds + AUX_OFF + 6144);
    unsigned* head = (unsigned*)(A->ws + WS_CTL) + CW_QHEAD;
    __syncthreads();
    if (tid == 0) {
        int first = MOE_TILES;
        if (need == 0u || __hip_atomic_load(done, __ATOMIC_RELAXED, __HIP_MEMORY_SCOPE_AGENT) < need) first = (int)__hip_atomic_fetch_add(head, 4u, __ATOMIC_RELAXED, __HIP_MEMORY_SCOPE_AGENT);
        qs[0] = first;
    }
    __syncthreads();
    int cur = qs[0], nxt = cur + 2, slot = 1, nb = 2, pend = 0;
    if (cur >= MOE_TILES) return;
    CvtTile c0, c1; f32x4 v0[8], v1[8];
    cvt_decode_moe(A, cur, c0); cvt_load<true>(c0, tid, v0);
    cvt_decode_moe(A, cur + 1, c1); cvt_load<true>(c1, tid, v1);
    while (cur < MOE_TILES) {
        bool more = false;
        if (tid == 0) { more = (nb < quota) && (nxt + 2 < limit) && (nxt < MOE_TILES);
            if (more && need != 0u) more = __hip_atomic_load(done, __ATOMIC_RELAXED, __HIP_MEMORY_SCOPE_AGENT) < need;
            if (more) pend = (int)__hip_atomic_fetch_add(head, 2u, __ATOMIC_RELAXED, __HIP_MEMORY_SCOPE_AGENT); }
        const bool hn = nxt < MOE_TILES;
        cvt_stage1(tid, lds, v0);
        CvtTile n0, n1;
        if (hn) { cvt_decode_moe(A, nxt, n0); cvt_load<true>(n0, tid, v0); }
        cvt_stage2<true>(c0, tid, lds);
        if (tid == 0) qs[slot] = more ? pend : MOE_TILES;
        cvt_stage1(tid, lds, v1);
        const int nn = qs[slot];
        if (hn) { cvt_decode_moe(A, nxt + 1, n1); cvt_load<true>(n1, tid, v1); }
        cvt_stage2<true>(c1, tid, lds);
        c0 = n0; c1 = n1; cur = nxt; nxt = nn; slot ^= 1; ++nb;
    }
    __syncthreads();
}
__device__ __forceinline__ void p0_prologue(KArgs A, char* lds) {
    const int tid = ltid(), G = gridDim.x, b = blockIdx.x;
    { const int lane = tid & 63, axis = lane >> 5, idx = lane & 31; float* tab = (float*)(A->ws + WS_ROPE);
      const float inv = exp2f(-(float)idx * (13.287712379549449f / 32.0f));
      for (int t = b * NWAVES + (tid >> 6); t < SEQ; t += G * NWAVES) { const float ang = (float)(axis ? (t & 63) : (t >> 6)) * inv;
          tab[(size_t)t * 128 + axis * 64 + idx] = cosf(ang); tab[(size_t)t * 128 + axis * 64 + 32 + idx] = sinf(ang); } }
    for (int it = b; it < 96; it += G) ada_item(A, lds, it);
    cvt_static_dense(A, lds);
}

__device__ __forceinline__ void moe_tile_table(KArgs A, int l, char* lds) {
    int* ts = (int*)(lds + AUX_OFF + 4096);
    const int t = ltid();
    if (t < NEXP) ts[120 + t] = (int)__hip_atomic_load((const unsigned*)(A->ws + WS_CTL) + CW_CNT + l * 2048 + 64 * t, __ATOMIC_RELAXED, __HIP_MEMORY_SCOPE_AGENT);
    __syncthreads();
    if (t <= NEXP) {
        int acc = 0, af = 0, ah = 0;
        for (int e = 0; e < NEXP; ++e) { const int cn = ts[120 + e]; const int nt_ = (cn + 255) >> 8;
            const int hf = (nt_ > 0 && (cn - (nt_ - 1) * 256) <= 128) ? 1 : 0;
            const bool in = e < t; acc += in ? nt_ : 0; af += in ? nt_ - hf : 0; ah += in ? hf : 0; }
        ts[t] = acc; ts[40 + t] = af; ts[80 + t] = ah;
    }
    __syncthreads();
}

__device__ __forceinline__ void row_load_f32(const float* p, int lane, f32x4 (&v)[8]) {
#pragma unroll
    for (int j = 0; j < 8; ++j) v[j] = *(const f32x4*)(p + 4 * lane + 256 * j);
}
__device__ __forceinline__ void row_load_bf16(const bf16_t* p, int lane, f32x4 (&v)[8]) {
#pragma unroll
    for (int j = 0; j < 8; ++j) { const u32x2 x = *(const u32x2*)(p + 4 * lane + 256 * j); v[j] = (f32x4){bflo(x.x), bfhi(x.x), bflo(x.y), bfhi(x.y)}; }
}
__device__ __forceinline__ void moe_combine(KArgs A, int l, int row, int lane, f32x4 (&v)[8], const int* ts) {
    const unsigned* rt = (const unsigned*)(A->ws + WS_ROUTE) + (size_t)row * 8;
    const float w0 = __uint_as_float(rt[4]), w1 = __uint_as_float(rt[5]); const unsigned s0 = (unsigned)ts[rt[0]] * 256u + rt[2], s1 = (unsigned)ts[rt[1]] * 256u + rt[3];
    const bf16_t* y0 = (const bf16_t*)(A->ws + WS_Y2) + (size_t)s0 * DM; const bf16_t* y1 = (const bf16_t*)(A->ws + WS_Y2) + (size_t)s1 * DM;
    const float* g = (const float*)(A->ws + WS_MOD) + (size_t)(l * 2 + (row < CTX ? 1 : 0)) * ADA + 5 * DM;
#pragma unroll
    for (int j = 0; j < 8; ++j) { const int c = 4 * lane + 256 * j;
        const u32x2 a = *(const u32x2*)(y0 + c), b = *(const u32x2*)(y1 + c); const f32x4 gg = *(const f32x4*)(g + c);
        v[j].x += gg.x * (w0 * bflo(a.x) + w1 * bflo(b.x)); v[j].y += gg.y * (w0 * bfhi(a.x) + w1 * bfhi(b.x));
        v[j].z += gg.z * (w0 * bflo(a.y) + w1 * bflo(b.y)); v[j].w += gg.w * (w0 * bfhi(a.y) + w1 * bfhi(b.y)); }
}
__device__ __forceinline__ float row_rstd(const f32x4 (&v)[8]) {
    float s = 0.f;
#pragma unroll
    for (int j = 0; j < 8; ++j) s += (v[j].x * v[j].x + v[j].y * v[j].y) + (v[j].z * v[j].z + v[j].w * v[j].w);
    return rsqrtf(wave_sum(s) * (1.0f / DM) + RMS_EPS);
}

template <int MODE>
__device__ __forceinline__ void rows_phase(KArgs A, int l, char* lds) {
    const int lc = (MODE == 2) ? DEPTH - 1 : l - 1;
    if (MODE != 0) moe_tile_table(A, lc, lds);
    const int* ts = (const int*)(lds + AUX_OFF + 4096);
    const int tid = ltid(), lane = tid & 63, wave = tid >> 6, gw = blockIdx.x * NWAVES + wave, NGW = gridDim.x * NWAVES;
    float* pv = (float*)lds;
    { const int c = tid * 4;
      if (MODE == 2) *(f32x4*)(pv + c) = *(const f32x4*)(A->in[I_FG] + c);
      else { const f32x4 g = *(const f32x4*)(A->in[I_N1G] + (size_t)l * DM + c);
#pragma unroll
          for (int s_ = 0; s_ < 2; ++s_) { const float* mod = (const float*)(A->ws + WS_MOD) + (size_t)(l * 2 + s_) * ADA;
              *(f32x4*)(pv + (2 * s_) * DM + c) = g * (*(const f32x4*)(mod + DM + c) + 1.0f); *(f32x4*)(pv + (2 * s_ + 1) * DM + c) = *(const f32x4*)(mod + c); } }
      if (MODE != 0) {
#pragma unroll
          for (int s_ = 0; s_ < 2; ++s_) *(f32x4*)(pv + (4 + s_) * DM + c) = *(const f32x4*)((const float*)(A->ws + WS_MOD) + (size_t)(lc * 2 + s_) * ADA + 5 * DM + c); } }
    __syncthreads();
    const int first = (MODE == 2) ? CTX : 0, nrows = TOK - first, RPW = nrows / NGW;
#define ROW_K(k) ((k) < RPW ? first + gw + (k) * NGW : ((wave == 0 && RPW * NGW + (int)blockIdx.x + ((k) - RPW) * (int)gridDim.x < nrows) ? first + RPW * NGW + (int)blockIdx.x + ((k) - RPW) * (int)gridDim.x : TOK))
#define ROW_RT(r_, ra_, rb_) do { const unsigned* rt_ = (const unsigned*)(A->ws + WS_ROUTE) + (size_t)(r_) * 8; ra_ = *(const u32x4*)rt_; rb_ = *(const u32x2*)(rt_ + 4); } while (0)
#define ROW_ISSUE(r_, V, YA, YB, W0, W1, ra_, rb_) do { \
        if (MODE == 0) row_load_f32((r_) < CTX ? A->in[I_CTX] + (size_t)(r_) * DM : A->in[I_X] + (size_t)((r_) - CTX) * DM, lane, V); \
        else { _Pragma("unroll") for (int j = 0; j < 8; ++j) { const u32x2 x_ = *(const u32x2*)((const bf16_t*)(A->ws + WS_XA) + (size_t)(r_) * DM + 4 * lane + 256 * j); V[j].x = __uint_as_float(x_.x); V[j].y = __uint_as_float(x_.y); }   \
            const unsigned s0_ = (unsigned)ts[ra_.x] * 256u + ra_.z, s1_ = (unsigned)ts[ra_.y] * 256u + ra_.w; W0 = __uint_as_float(rb_.x); W1 = __uint_as_float(rb_.y); \
            const bf16_t* y0_ = (const bf16_t*)(A->ws + WS_Y2) + (size_t)s0_ * DM; const bf16_t* y1_ = (const bf16_t*)(A->ws + WS_Y2) + (size_t)s1_ * DM; \
            _Pragma("unroll") for (int j = 0; j < 8; ++j) { YA[j] = *(const u32x2*)(y0_ + 4 * lane + 256 * j); YB[j] = *(const u32x2*)(y1_ + 4 * lane + 256 * j); } } } while (0)
    auto body = [&](f32x4 (&v)[8], const u32x2 (&ya)[8], const u32x2 (&yb)[8], const float w0, const float w1, const int row) {
        const int s_ = row < CTX ? 1 : 0;
        if (MODE != 0) {
#pragma unroll
            for (int j = 0; j < 8; ++j) { const unsigned a_ = __float_as_uint(v[j].x), b_ = __float_as_uint(v[j].y); v[j] = (f32x4){bflo(a_), bfhi(a_), bflo(b_), bfhi(b_)}; }
#pragma unroll
            for (int j = 0; j < 8; ++j) { const f32x4 gg = *(const f32x4*)(pv + (4 + s_) * DM + 4 * lane + 256 * j); const u32x2 a = ya[j], b = yb[j];
                v[j].x += gg.x * (w0 * bflo(a.x) + w1 * bflo(b.x)); v[j].y += gg.y * (w0 * bfhi(a.x) + w1 * bfhi(b.x));
                v[j].z += gg.z * (w0 * bflo(a.y) + w1 * bflo(b.y)); v[j].w += gg.w * (w0 * bfhi(a.y) + w1 * bfhi(b.y)); }
        }
        float rstd = row_rstd(v);
        if (MODE == 2) {
#if PROBE_ATTN || PROBE_P2B
            { const float* pw = (const float*)(A->ws + WS_CTL) + CW_PRB; rstd *= 1.0f + sqrtf(pw[0] / pw[64]); }
#endif
            float* o = A->out + (size_t)(row - CTX) * DM;
#pragma unroll
            for (int j = 0; j < 8; ++j) { const int c = 4 * lane + 256 * j; *(f32x4*)(o + c) = v[j] * rstd * *(const f32x4*)(pv + c); }
        } else {
            if (MODE == 1) { bf16_t* xb = (bf16_t*)(A->ws + WS_XB) + (size_t)row * DM;
#pragma unroll
                for (int j = 0; j < 8; ++j) { u32x2 o; o.x = cvt_pk_bf16(v[j].x, v[j].y); o.y = cvt_pk_bf16(v[j].z, v[j].w); *(u32x2*)(xb + 4 * lane + 256 * j) = o; } }
#pragma unroll
            for (int j = 0; j < 8; ++j) { const int c = 4 * lane + 256 * j;
                const f32x4 y = v[j] * rstd * *(const f32x4*)(pv + (2 * s_) * DM + c) + *(const f32x4*)(pv + (2 * s_ + 1) * DM + c);
                *(unsigned*)(A->ws + WS_H8 + (size_t)row * DM + c) = pk_fp8x4(y); }
        }
    };
    f32x4 vA[8], vB[8]; u32x2 yaA[8], ybA[8], yaB[8], ybB[8]; float w0A = 0.f, w1A = 0.f, w0B = 0.f, w1B = 0.f;
    u32x4 raA = (u32x4){0u, 0u, 0u, 0u}, raB = raA; u32x2 rbA = (u32x2){0u, 0u}, rbB = rbA;
    int k = 0, rowA = ROW_K(0), rowB = ROW_K(1);
    if (MODE != 0) { if (rowA < TOK) ROW_RT(rowA, raA, rbA); if (rowB < TOK) ROW_RT(rowB, raB, rbB); }
    if (rowA < TOK) ROW_ISSUE(rowA, vA, yaA, ybA, w0A, w1A, raA, rbA);
    if (rowB < TOK) ROW_ISSUE(rowB, vB, yaB, ybB, w0B, w1B, raB, rbB);
    if (MODE != 0) { const int r2 = ROW_K(2), r3 = ROW_K(3); if (r2 < TOK) ROW_RT(r2, raA, rbA); if (r3 < TOK) ROW_RT(r3, raB, rbB); }
    for (;;) {
        if (rowA >= TOK) break;
        body(vA, yaA, ybA, w0A, w1A, rowA);
        __builtin_amdgcn_sched_barrier(0);
        rowA = ROW_K(k + 2);
        if (rowA < TOK) { ROW_ISSUE(rowA, vA, yaA, ybA, w0A, w1A, raA, rbA); if (MODE != 0) { const int r4 = ROW_K(k + 4); if (r4 < TOK) ROW_RT(r4, raA, rbA); } }
        __builtin_amdgcn_sched_barrier(0);
        if (rowB >= TOK) break;
        body(vB, yaB, ybB, w0B, w1B, rowB);
        __builtin_amdgcn_sched_barrier(0);
        rowB = ROW_K(k + 3);
        if (rowB < TOK) { ROW_ISSUE(rowB, vB, yaB, ybB, w0B, w1B, raB, rbB); if (MODE != 0) { const int r5 = ROW_K(k + 5); if (r5 < TOK) ROW_RT(r5, raB, rbB); } }
        __builtin_amdgcn_sched_barrier(0);
        k += 2;
    }
#undef ROW_K
#undef ROW_RT
#undef ROW_ISSUE
}
__device__ __forceinline__ void p1_norm1(KArgs A, int l, char* lds) { if (l == 0) rows_phase<0>(A, l, lds); else rows_phase<1>(A, l, lds); }
__device__ __forceinline__ void p_final(KArgs A, char* lds) { rows_phase<2>(A, DEPTH - 1, lds); }

__device__ __forceinline__ f32x4 ld_bf4(const bf16_t* p) { const u32x2 x = *(const u32x2*)p; return (f32x4){bflo(x.x), bfhi(x.x), bflo(x.y), bfhi(x.y)}; }
__device__ __forceinline__ void st_bf4(bf16_t* p, const f32x4 v) { u32x2 o; o.x = cvt_pk_bf16(v.x, v.y); o.y = cvt_pk_bf16(v.z, v.w); *(u32x2*)p = o; }
__device__ __forceinline__ f32x4 rope4(const f32x4 x, const f32x4 cs, const f32x4 sn, float sgn) {
    const int l4 = lane4_fresh(); f32x4 p; p.x = shx(x.x, 8, l4); p.y = shx(x.y, 8, l4); p.z = shx(x.z, 8, l4); p.w = shx(x.w, 8, l4);
    return x * cs + p * sn * sgn;
}
__device__ __forceinline__ float sum32(float v) { const int l4 = lane4_fresh(); v += shx(v, 1, l4); v += shx(v, 2, l4); v += shx(v, 4, l4); v += shx(v, 8, l4); v += shx(v, 16, l4); return v; }
__device__ __forceinline__ void p2b_post(KArgs A, int l, char* lds) {
    const int tid = ltid(), lane = tid & 63, gw = blockIdx.x * NWAVES + (tid >> 6), NGW = gridDim.x * NWAVES;
    unsigned* vx = (unsigned*)lds;
    const bf16_t* P = (const bf16_t*)(A->ws + WS_P);
    bf16_t* QG = (bf16_t*)(A->ws + WS_QG); bf16_t* QW = (bf16_t*)(A->ws + WS_QW); bf16_t* KG = (bf16_t*)(A->ws + WS_KG); bf16_t* KW = (bf16_t*)(A->ws + WS_KW);
    bf16_t* VG = (bf16_t*)(A->ws + WS_VG); bf16_t* VW = (bf16_t*)(A->ws + WS_VW); bf16_t* DP = (bf16_t*)(A->ws + WS_DP);
    unsigned char* Q8G = A->ws + WS_Q8G; unsigned char* Q8W = A->ws + WS_Q8W; unsigned char* K8G = A->ws + WS_K8G; unsigned char* K8W = A->ws + WS_K8W;
    unsigned char* VTG = A->ws + WS_VTG; unsigned char* VTW = A->ws + WS_VTW;
    const int j = lane & 31, q = j >> 3, dd = 4 * j;
    const float sgn = (q & 1) ? 1.f : -1.f;
    const f32x4 qg = *(const f32x4*)(A->in[I_QNG] + l * HD + dd), kg = *(const f32x4*)(A->in[I_KNG] + l * HD + dd);
    const float* tab = (const float*)(A->ws + WS_ROPE);
    for (int row = gw; row < TOK; row += NGW) {
        const bool lat = row >= CTX; const int t = row - CTX;
        const bf16_t* pr = P + (size_t)row * INW;
        const int sb = lat ? CTX : 0, tp = lat ? t : row, ls = lat ? SEQ : CTX;
        u32x2 rgq[4], rwq[4], ru[4], rgk, rwk, rgv, rwv, w2[2], w4[4], w8[8], w16[16];
#pragma unroll
        for (int hp = 0; hp < 4; ++hp) { rgq[hp] = *(const u32x2*)(pr + OFF_GQ + hp * 256 + 4 * lane); rwq[hp] = *(const u32x2*)(pr + OFF_WQ + hp * 256 + 4 * lane); ru[hp] = *(const u32x2*)(pr + hp * 256 + 4 * lane); }
        rgk = *(const u32x2*)(pr + OFF_GK + 4 * lane); rwk = *(const u32x2*)(pr + OFF_WK + 4 * lane); rgv = *(const u32x2*)(pr + OFF_GV + 4 * lane); rwv = *(const u32x2*)(pr + OFF_WV + 4 * lane);
#define P2B_WIN(arr, g, w) _Pragma("unroll") for (int i = 0; i < (w); ++i) { const int rr = tp - ((w) - 1) / 2 + i; const int rc = rr < 0 ? 0 : (rr >= ls ? ls - 1 : rr); arr[i] = *(const u32x2*)(P + (size_t)(sb + rc) * INW + (g) * 256 + lane * 4); }
        P2B_WIN(w2, 0, 2) P2B_WIN(w4, 1, 4) P2B_WIN(w8, 2, 8) P2B_WIN(w16, 3, 16)
#undef P2B_WIN
        f32x4 cs = {1.f, 1.f, 1.f, 1.f}, sn = {0.f, 0.f, 0.f, 0.f};
        if (lat) { const float* tp_ = tab + (size_t)t * 128 + (q >> 1) * 64 + 4 * (j & 7); cs = *(const f32x4*)tp_; sn = *(const f32x4*)(tp_ + 32); }
#define BF4(v) ((f32x4){bflo((v).x), bfhi((v).x), bflo((v).y), bfhi((v).y)})
#pragma unroll
        for (int hp = 0; hp < 4; ++hp) {
            f32x4 x = BF4(rgq[hp]);
            const float r = rsqrtf(sum32((x.x * x.x + x.y * x.y) + (x.z * x.z + x.w * x.w)) * (1.0f / HD) + RMS_EPS);
            x = x * r * qg;
            const f32x4 y = rope4(x, cs, sn, sgn);
            if (PROBE_ATTN) st_bf4(QG + (size_t)row * MIXW + hp * 256 + 4 * lane, y);
            *(unsigned*)(Q8G + (size_t)row * MIXW + hp * 256 + 4 * lane) = pk_fp8x4(y * (8.0f * att::SCALE * 1.4426950408889634f));
        }
        {
            f32x4 x = BF4(rgk);
            const float r = rsqrtf(sum32((x.x * x.x + x.y * x.y) + (x.z * x.z + x.w * x.w)) * (1.0f / HD) + RMS_EPS);
            x = x * r * kg;
            const f32x4 y = rope4(x, cs, sn, sgn);
            if (PROBE_ATTN) st_bf4(KG + (size_t)row * 256 + 4 * lane, y);
            *(unsigned*)(K8G + (size_t)row * 256 + 4 * lane) = pk_fp8x4(y);
        }
#pragma unroll
        for (int hp = 0; hp < 4; ++hp) { const f32x4 y = rope4(BF4(rwq[hp]), cs, sn, sgn);
            if (PROBE_ATTN) st_bf4(QW + (size_t)row * MIXW + hp * 256 + 4 * lane, y);
            *(unsigned*)(Q8W + (size_t)row * MIXW + hp * 256 + 4 * lane) = pk_fp8x4(y * (8.0f * att::SCALE * 1.4426950408889634f)); }
        { const f32x4 y = rope4(BF4(rwk), cs, sn, sgn);
          if (PROBE_ATTN) st_bf4(KW + (size_t)row * 256 + 4 * lane, y);
          *(unsigned*)(K8W + (size_t)row * 256 + 4 * lane) = pk_fp8x4(y); }
        if (PROBE_ATTN) { *(u32x2*)(VG + (size_t)row * 256 + lane * 4) = rgv; *(u32x2*)(VW + (size_t)row * 256 + lane * 4) = rwv; }
        {
            const int wv_ = tid >> 6;
            vx[(wv_ * 2 + 0) * 64 + lane] = pk_fp8x4(BF4(rgv));
            vx[(wv_ * 2 + 1) * 64 + lane] = pk_fp8x4(BF4(rwv));
        }
#define P2B_POOL(arr, g, w) { f32x4 s_ = {0.f, 0.f, 0.f, 0.f}; int cnt_ = 0; _Pragma("unroll") for (int i = 0; i < (w); ++i) { const int rr = tp - ((w) - 1) / 2 + i; const bool ok = (rr >= 0) && (rr < ls); \
            s_ += ok ? BF4(arr[i]) : (f32x4){0.f, 0.f, 0.f, 0.f}; cnt_ += ok ? 1 : 0; } \
            st_bf4(DP + (size_t)row * MIXW + (g) * 256 + lane * 4, s_ * (1.0f / (float)cnt_) - BF4(ru[g])); }
        P2B_POOL(w2, 0, 2) P2B_POOL(w4, 1, 4) P2B_POOL(w8, 2, 8) P2B_POOL(w16, 3, 16)
#undef P2B_POOL
#undef BF4
        __syncthreads();
        { const int R0 = row - (tid >> 6), tile = R0 >> 6, kap0 = R0 & 63, sb = 4 * ((kap0 & 31) >> 3) + 16 * (kap0 >> 5);
          const int buf = tid >> 8, n = tid & 255, kvh = n >> 7, nn = n & 127, ln = n >> 2, by = (n & 3) * 8;
          unsigned d0 = 0, d1 = 0;
#pragma unroll
          for (int w = 0; w < 4; ++w) { d0 |= ((vx[(w * 2 + buf) * 64 + ln] >> by) & 0xffu) << (8 * w); d1 |= ((vx[((w + 4) * 2 + buf) * 64 + ln] >> by) & 0xffu) << (8 * w); }
          unsigned char* img = (buf ? VTW : VTG) + ((size_t)tile * 2 + kvh) * 8192 + (size_t)nn * 64;
          const int sw_ = (nn >> 2) & 3;
          *(unsigned*)(img + ((((sb >> 4) ^ sw_)) << 4) + (sb & 15)) = d0;
          *(unsigned*)(img + (((((sb + 32) >> 4) ^ sw_)) << 4) + (sb & 15)) = d1; }
        __syncthreads();
    }
}

__device__ __forceinline__ void p6_norm2_route(KArgs A, int l, char* lds) {
    const int tid = ltid(), wave = tid >> 6, lane = tid & 63;
    float* hrow = (float*)lds;
    float* scr = (float*)(lds + AUX_OFF);
    const float* g2 = A->in[I_N2G] + (size_t)l * DM;
    const float* rw = A->in[I_RW]; const float* rb = A->in[I_RB];
    unsigned* cnt = (unsigned*)(A->ws + WS_CTL) + CW_CNT + l * 2048;
    for (int pass = blockIdx.x + (l == DEPTH - 1 ? CTX / 16 : 0); pass < TOK / 16; pass += gridDim.x) {
        const int r0 = pass * 16;
#pragma unroll 1
        for (int q = 0; q < 2; ++q) {
            const int rl = wave * 2 + q, row = r0 + rl;
            f32x4 v[8]; row_load_bf16((const bf16_t*)(A->ws + WS_XA) + (size_t)row * DM, lane, v);
            const float rstd = row_rstd(v);
            const float* mod = (const float*)(A->ws + WS_MOD) + (size_t)(l * 2 + (row < CTX ? 1 : 0)) * ADA;
            unsigned char* h = (unsigned char*)(A->ws + WS_H2) + (size_t)row * DM;
            f32x4 gg[8], sh[8], sc[8];
#pragma unroll
            for (int j = 0; j < 8; ++j) { const int c = 4 * lane + 256 * j; gg[j] = *(const f32x4*)(g2 + c); sh[j] = *(const f32x4*)(mod + 3 * DM + c); sc[j] = *(const f32x4*)(mod + 4 * DM + c); }
#pragma unroll
            for (int j = 0; j < 8; ++j) { const int c = 4 * lane + 256 * j;
                const f32x4 y = v[j] * rstd * gg[j] * (sc[j] + 1.0f) + sh[j];
                *(f32x4*)(hrow + rl * DM + c) = y;
                *(unsigned*)(h + c) = pk_fp8x4(y); }
        }
        __syncthreads();
        { const int e = tid & 31, ks = tid >> 5; const float* hk = hrow + ks * 128; const float* wk = rw + (size_t)(ks * 128) * NEXP + e;
          float acc[16];
#pragma unroll
          for (int r = 0; r < 16; ++r) acc[r] = 0.f;
          for (int k = 0; k < 128; k += 16) {
              float w[16];
#pragma unroll
              for (int u = 0; u < 16; ++u) w[u] = wk[(size_t)(k + u) * NEXP];
#pragma unroll
              for (int q = 0; q < 4; ++q) {
#pragma unroll
                  for (int r = 0; r < 16; ++r) { const f32x4 h4 = *(const f32x4*)(hk + r * DM + k + 4 * q);
                      acc[r] = fmaf(h4.x, w[4 * q], acc[r]); acc[r] = fmaf(h4.y, w[4 * q + 1], acc[r]); acc[r] = fmaf(h4.z, w[4 * q + 2], acc[r]); acc[r] = fmaf(h4.w, w[4 * q + 3], acc[r]); }
              }
          }
const int l4x = lane4_fresh();
#pragma unroll
          for (int r = 0; r < 16; ++r) acc[r] += shx(acc[r], 32, l4x);
          __syncthreads();
          if (lane < 32) {
#pragma unroll
              for (int r = 0; r < 16; ++r) hrow[(wave * 16 + r) * 32 + lane] = acc[r]; }
          __syncthreads();
          { const int rl = tid >> 5; float logit = 0.f;
#pragma unroll
            for (int wv = 0; wv < 8; ++wv) logit += hrow[(wv * 16 + rl) * 32 + e];
            scr[rl * 32 + e] = 1.0f / (1.0f + expf(-logit)); } }
        __syncthreads();
        if (tid < 16) {
            const int row = r0 + tid; const float* sc = scr + tid * 32;
            int bg = 0; float bgs = -1e30f;
            for (int g = 0; g < 4; ++g) { float m1 = -1e30f, m2 = -1e30f;
                for (int i = 0; i < 8; ++i) { const float s = sc[g * 8 + i] + rb[g * 8 + i]; if (s > m1) { m2 = m1; m1 = s; } else if (s > m2) m2 = s; }
                const float gs = m1 + m2; if (gs > bgs) { bgs = gs; bg = g; } }
            int i1 = 0, i2 = 0; float m1 = -1e30f, m2 = -1e30f;
            for (int i = 0; i < 8; ++i) { const float s = sc[bg * 8 + i] + rb[bg * 8 + i]; if (s > m1) { m2 = m1; i2 = i1; m1 = s; i1 = i; } else if (s > m2) { m2 = s; i2 = i; } }
            const int e0 = bg * 8 + i1, e1 = bg * 8 + i2; const float w0 = sc[e0], w1 = sc[e1], ws = w0 + w1;
            const unsigned p0 = __hip_atomic_fetch_add(cnt + 64 * e0, 1u, __ATOMIC_RELAXED, __HIP_MEMORY_SCOPE_AGENT);
            const unsigned p1 = __hip_atomic_fetch_add(cnt + 64 * e1, 1u, __ATOMIC_RELAXED, __HIP_MEMORY_SCOPE_AGENT);
            unsigned* rt = (unsigned*)(A->ws + WS_ROUTE) + (size_t)row * 8;
            rt[0] = (unsigned)e0; rt[1] = (unsigned)e1; rt[2] = p0; rt[3] = p1; rt[4] = __float_as_uint(w0 / ws); rt[5] = __float_as_uint(w1 / ws);
            unsigned* ix = (unsigned*)(A->ws + WS_XS); ix[(size_t)e0 * TOK + p0] = (unsigned)row; ix[(size_t)e1 * TOK + p1] = (unsigned)row;
        }
        __syncthreads();
    }
}

#ifndef PROBE_P2B
#define PROBE_P2B 0
#endif
#if PROBE_P2B
__device__ __forceinline__ void probe_p2b(KArgs A, int l) {
    const int tid = ltid(), lane = tid & 63, gw = blockIdx.x * NWAVES + (tid >> 6);
    const int ridx = gw;
    int row = (ridx < 64) ? ridx * 4 + (ridx & 3) : (ridx < 128 ? TOK - 1 - (ridx - 64) : CTX + (int)(((unsigned)ridx * 2654435761u >> 7) % (unsigned)SEQ));
    const bf16_t* P = (const bf16_t*)(A->ws + WS_P) + (size_t)row * INW;
    const bool lat = row >= CTX; const int t = row - CTX;
    float sd = 0.f, sr = 0.f;
    for (int hh = 0; hh < 20; ++hh) {
        int off; const bf16_t* O; bool nrm; const float* gn = nullptr;
        if (hh < 8) { off = OFF_GQ + hh * HD; O = (const bf16_t*)(A->ws + WS_QG) + (size_t)row * MIXW + hh * HD; nrm = true; gn = A->in[I_QNG] + l * HD; }
        else if (hh < 10) { off = OFF_GK + (hh - 8) * HD; O = (const bf16_t*)(A->ws + WS_KG) + (size_t)row * 256 + (hh - 8) * HD; nrm = true; gn = A->in[I_KNG] + l * HD; }
        else if (hh < 18) { off = OFF_WQ + (hh - 10) * HD; O = (const bf16_t*)(A->ws + WS_QW) + (size_t)row * MIXW + (hh - 10) * HD; nrm = false; }
        else { off = OFF_WK + (hh - 18) * HD; O = (const bf16_t*)(A->ws + WS_KW) + (size_t)row * 256 + (hh - 18) * HD; nrm = false; }
        float ss = 0.f; for (int d = 0; d < HD; ++d) { const float x = bf2f(P[off + d]); ss += x * x; }
        const float r = nrm ? 1.0f / sqrtf(ss / (float)HD + RMS_EPS) : 1.0f;
        for (int d = lane; d < HD; d += 64) {
            const float x = bf2f(P[off + d]) * r * (nrm ? gn[d] : 1.0f);
            float y = x;
            if (lat) { const int half = d >> 6, dd = d & 63, i = dd & 31; const float pos = half ? (float)(t & 63) : (float)(t >> 6);
                const float ang = pos * powf(10000.0f, -(float)i / 32.0f); const int pd = (dd < 32) ? d + 32 : d - 32;
                const float xp = bf2f(P[off + pd]) * r * (nrm ? gn[pd] : 1.0f); const float rot = (dd < 32) ? -xp : xp;
                y = x * cosf(ang) + rot * sinf(ang); }
            const float o = bf2f(O[d]); sd += (o - y) * (o - y); sr += y * y;
        }
    }
    {
        const int sb = lat ? CTX : 0, tp = lat ? t : row, ls = lat ? SEQ : CTX; const bf16_t* Pb = (const bf16_t*)(A->ws + WS_P);
        const bf16_t* DPr = (const bf16_t*)(A->ws + WS_DP) + (size_t)row * MIXW;
        for (int c = lane; c < MIXW; c += 64) { const int g = c >> 8, w = 2 << g; int lo = tp - (w - 1) / 2, hi = tp + w / 2 + 1; lo = lo < 0 ? 0 : lo; hi = hi > ls ? ls : hi;
            float s = 0.f; for (int rr = lo; rr < hi; ++rr) s += bf2f(Pb[(size_t)(sb + rr) * INW + c]);
            const float y = s / (float)(hi - lo) - bf2f(P[c]); const float o = bf2f(DPr[c]); sd += (o - y) * (o - y); sr += y * y; }
    }
    sd = wave_sum(sd); sr = wave_sum(sr);
    if (lane == 0) { float* pw = (float*)(A->ws + WS_CTL) + CW_PRB; atomicAdd(pw, sd); atomicAdd(pw + 64, sr); }
}
#endif

#ifndef PROBE_ATTN
#define PROBE_ATTN 0
#endif
#if PROBE_ATTN
__device__ __forceinline__ void probe_attn(KArgs A, int l, char* lds) {
    const int tid = ltid(), lane = tid & 63, wave = tid >> 6, gw = blockIdx.x * NWAVES + wave;
    float* qs = (float*)(lds + wave * 1024);
    const int type = gw & 1, h = (gw >> 1) & 7, ridx = gw >> 4, kvh = h >> 2;
    int row; bool isc = false;
    if (ridx < 8) { row = (ridx * 37) & 255; isc = true; if (l != 0) return; }
    else if (ridx < 40) { const int k = ridx - 8; row = CTX + ((k & 1) ? SEQ - 1 - (k >> 1) * 61 : (k >> 1) * 63); }
    else row = CTX + (int)(((unsigned)ridx * 2654435761u >> 8) % (unsigned)SEQ);
    const bf16_t* Q = (const bf16_t*)(A->ws + (type ? WS_QW : WS_QG)); const bf16_t* K = (const bf16_t*)(A->ws + (type ? WS_KW : WS_KG)); const bf16_t* V = (const bf16_t*)(A->ws + (type ? WS_VW : WS_VG));
    const unsigned char* O = A->ws + WS_YB + (size_t)(1 + type) * YB_STRIDE * 2;
    for (int d = lane; d < HD; d += 64) { qs[d] = bf2f(Q[(size_t)row * MIXW + h * HD + d]); qs[128 + d] = (float)(((d * 37 + 11) % 13) - 6); }
    asm volatile("s_waitcnt lgkmcnt(0)" ::: "memory");
    float num = 0.f, den = 0.f;
    const int t = row - CTX;
    const int nk = (type == 0) ? (isc ? CTX : TOK) : (isc ? CTX : CTX + 257);
    for (int j = lane; j < nk; j += 64) {
        int kr;
        if (type == 0 || j < CTX) kr = j; else { const int kp = t - 128 + (j - CTX); if (kp < 0 || kp >= SEQ) continue; kr = CTX + kp; }
        const bf16_t* kp_ = K + (size_t)kr * 256 + kvh * HD; const bf16_t* vp_ = V + (size_t)kr * 256 + kvh * HD;
        float dot = 0.f, vr = 0.f;
        for (int d = 0; d < HD; ++d) { dot += qs[d] * bf2f(kp_[d]); vr += qs[128 + d] * bf2f(vp_[d]); }
        const float p = expf(dot * 0.088388347648318440f); num += p * vr; den += p;
    }
    num = wave_sum(num); den = wave_sum(den);
    if (type == 1) den += expf(A->in[I_SINK][l * 8 + h]);
    const float naive = num / den;
    float fast = 0.f;
    for (int d = lane; d < HD; d += 64) fast += qs[128 + d] * (__builtin_amdgcn_cvt_f32_fp8((int)O[(size_t)row * MIXW + h * HD + d], 0) * (1.0f / 32.0f));
    fast = wave_sum(fast);
    if (lane == 0) { float* pw = (float*)(A->ws + WS_CTL) + CW_PRB; atomicAdd(pw, (naive - fast) * (naive - fast)); atomicAdd(pw + 64, naive * naive); }
}
#endif

struct SchedDense {
    int nM, nN, nwg, G, c; const char* A; const char* B; size_t at, bt; int pbase, pcut, pskip;
    __device__ __forceinline__ bool next(int i, pg8::Unit& u) const {
        const long L = (long)i * G + c; if (L >= nwg) return false;
        int wgid = (int)L; { const int q = nwg / 8, r = nwg % 8, xcd = wgid % 8, off = wgid / 8; wgid = (xcd < r ? xcd * (q + 1) : r * (q + 1) + (xcd - r) * q) + off; }
        const int nig = 8 * nN, gid = wgid / nig, fm = gid * 8, gsz = (nM - fm) < 8 ? (nM - fm) : 8;
        u.pm = fm + ((wgid % nig) % gsz); { const int pl = (wgid % nig) / gsz; u.pn = pbase + pl + (pl >= pcut ? pskip : 0); } u.e = 0; u.half = 0; u.a = A + (size_t)u.pm * at; u.b = B + (size_t)u.pn * bt; return true;
    }
};
__device__ __forceinline__ void xcd_pos(int c, int& mi, int& pn) { const int j = c >> 3; pn = j & 7; mi = 4 * (c & 7) + (j >> 3); }
struct SchedMerge {
    int npos, G, c; const char* Y; const char* W; int nbr, b0, esz;
    __device__ __forceinline__ bool next(int i, pg8::Unit& u) const {
        const int r = i / nbr, nb = b0 + i % nbr; int pm, pn;
        if (G == 256) { if (r == 0) { int mi; xcd_pos(c, mi, pn); pm = 1 + mi; } else if (r == 1 && c < npos - 256) { pm = 0; pn = c; } else return false; }
        else { const int pos = r * G + c; if (pos >= npos) return false; pm = (pos / 8 + 1) % 33; pn = pos % 8; }
        u.pm = pm; u.pn = pn; u.e = nb; u.half = 0;
        u.a = Y + (size_t)nb * YB_STRIDE * 2 + (size_t)u.pm * 256 * MIXW * esz; u.b = W + (size_t)nb * DM * MIXW * 2 + (size_t)u.pn * 256 * MIXW * esz; return true;
    }
};
struct SchedOut {
    int npos, G, c; const char* Am; const char* W;
    __device__ __forceinline__ bool next(int i, pg8::Unit& u) const {
        int pm, pn;
        if (G == 256) { if (i == 0) { int mi; xcd_pos(c, mi, pn); pm = 1 + mi; } else if (i == 1 && c < npos - 256) { pm = 0; pn = c; } else return false; }
        else { const int pos = i * G + c; if (pos >= npos) return false; pm = (pos / 8 + 1) % 33; pn = pos % 8; }
        u.pm = pm; u.pn = pn; u.e = 0; u.half = 0; u.a = Am + (size_t)u.pm * 256 * DM; u.b = W + (size_t)u.pn * 256 * DM; return true;
    }
};
struct SchedPool {
    int G, c; const char* Dp; const char* W;
    __device__ __forceinline__ bool next(int i, pg8::Unit& u) const {
        const int idx = i * G + c; if (idx < 0 || idx >= 132) return false;
        u.pm = idx / 4; u.e = idx % 4; u.pn = 0; u.half = 0; u.a = Dp + ((size_t)u.pm * 256 * MIXW + u.e * 256) * 2; u.b = W + (size_t)u.e * 256 * 256 * 2; return true;
    }
};
struct SchedMoe {
    int G, c; const int* ts; const char* Ab; const char* Wb; size_t at, wexp, wt; const unsigned* idx;
    __device__ __forceinline__ int a_row(const pg8::Unit& u, int r) const { const int pos = (u.pm - ts[u.e]) * 256 + r; return pos < ts[120 + u.e] ? (int)idx[(size_t)u.e * TOK + pos] : 0; }
    __device__ __forceinline__ int nunits() const { return ts[NEXP] * 8; }
    __device__ __forceinline__ bool next(int i, pg8::Unit& u) const {
        int j, pn_;
        if (G == 256) { int mi; xcd_pos(c, mi, pn_); j = i * 32 + mi; if (j >= ts[NEXP]) return false; }
        else { const int L = i * G + c; if (L >= ts[NEXP] * 8) return false; j = L >> 3; pn_ = L & 7; }
        const int nf = ts[40 + NEXP]; int e = 0, gm, hf;
        if (j < nf) { for (int k = 1; k < NEXP; ++k) e += (ts[40 + k] <= j) ? 1 : 0; gm = ts[e] + (j - ts[40 + e]); hf = 0; }
        else { j -= nf; for (int k = 1; k < NEXP; ++k) e += (ts[80 + k] <= j) ? 1 : 0; gm = ts[e + 1] - 1; hf = 1; }
        u.pm = gm; u.pn = pn_; u.e = e; u.half = hf; u.a = Ab + (size_t)gm * at; u.b = Wb + (size_t)e * wexp + (size_t)u.pn * wt; return true;
    }
};

typedef f32x4 AccT[2][2][4][2];
__device__ __forceinline__ u32x4 pack8(const f32x4 v0, const f32x4 v1) { u32x4 w; w.x = cvt_pk_bf16(v0[0], v0[1]); w.y = cvt_pk_bf16(v0[2], v0[3]); w.z = cvt_pk_bf16(v1[0], v1[1]); w.w = cvt_pk_bf16(v1[2], v1[3]); return w; }
__device__ __forceinline__ f32x4 sig4(const f32x4 v) { return (f32x4){sigmoidf_(v[0]), sigmoidf_(v[1]), sigmoidf_(v[2]), sigmoidf_(v[3])}; }

struct EpiP {
    static constexpr bool PERM = true; bf16_t* P;
    __device__ __forceinline__ void operator()(const AccT& acc, const pg8::Unit& u, int wr, int wc, int fr, int fq, const float fs) const {
        const int row0 = u.pm * 256 + wr * 64 + fr, col0 = u.pn * 256 + wc * 32 + 8 * fq; const bool sg = u.pn >= 16;
#pragma unroll
        for (int ai = 0; ai < 2; ++ai)
#pragma unroll
            for (int m = 0; m < 4; ++m) { bf16_t* rowp = P + (size_t)(row0 + ai * 128 + m * 16) * INW + col0;
#pragma unroll
                for (int bj = 0; bj < 2; ++bj) { f32x4 v0 = acc[ai][bj][m][0] * fs, v1 = acc[ai][bj][m][1] * fs;
                    if (sg) { v0 = sig4(v0); v1 = sig4(v1); }
                    *(u32x4*)(rowp + bj * 128) = pack8(v0, v1); } }
    }
};
struct EpiPool {
    static constexpr bool PERM = true; unsigned char* Y; const float* ps;
    __device__ __forceinline__ void operator()(const AccT& acc, const pg8::Unit& u, int wr, int wc, int fr, int fq, const float fs) const {
        const int row0 = u.pm * 256 + wr * 64 + fr, col0 = u.e * 256 + wc * 32 + 8 * fq;
        f32x4 s[2][2];
#pragma unroll
        for (int bj = 0; bj < 2; ++bj) { s[bj][0] = *(const f32x4*)(ps + col0 + bj * 128) * W8_SCALE; s[bj][1] = *(const f32x4*)(ps + col0 + bj * 128 + 4) * W8_SCALE; }
#pragma unroll
        for (int ai = 0; ai < 2; ++ai)
#pragma unroll
            for (int m = 0; m < 4; ++m) { unsigned char* rowp = Y + (size_t)(row0 + ai * 128 + m * 16) * MIXW + col0;
#pragma unroll
                for (int bj = 0; bj < 2; ++bj) { u32x2 o8; o8.x = pk_fp8x4(acc[ai][bj][m][0] * s[bj][0]); o8.y = pk_fp8x4(acc[ai][bj][m][1] * s[bj][1]); *(u32x2*)(rowp + bj * 128) = o8; } }
    }
};
struct EpiMerge {
    static constexpr bool PERM = true; const bf16_t* P; bf16_t* MG; unsigned char* MG8;
    __device__ __forceinline__ void operator()(const AccT& acc, const pg8::Unit& u, int wr, int wc, int fr, int fq, const float fs) const {
        const int row0 = u.pm * 256 + wr * 64 + fr, col0 = u.pn * 256 + wc * 32 + 8 * fq, nb = u.e;
#pragma unroll
        for (int ai = 0; ai < 2; ++ai) {
            u32x4 gv[4][2], ov[4][2];
#pragma unroll
            for (int m = 0; m < 4; ++m) { const size_t row = (size_t)(row0 + ai * 128 + m * 16);
                const bf16_t* gp = P + row * INW + OFF_GATE + nb * DM + col0; const bf16_t* op = MG + row * DM + col0;
#pragma unroll
                for (int bj = 0; bj < 2; ++bj) { gv[m][bj] = *(const u32x4*)(gp + bj * 128); if (nb != 0) ov[m][bj] = *(const u32x4*)(op + bj * 128); } }
#pragma unroll
            for (int m = 0; m < 4; ++m) { const size_t ro = (size_t)(row0 + ai * 128 + m * 16) * DM + col0;
#pragma unroll
                for (int bj = 0; bj < 2; ++bj) { const u32x4 g = gv[m][bj];
                    f32x4 v0 = (acc[ai][bj][m][0] * fs) * (f32x4){bflo(g.x), bfhi(g.x), bflo(g.y), bfhi(g.y)}, v1 = (acc[ai][bj][m][1] * fs) * (f32x4){bflo(g.z), bfhi(g.z), bflo(g.w), bfhi(g.w)};
                    if (nb != 0) { const u32x4 o = ov[m][bj]; v0 += (f32x4){bflo(o.x), bfhi(o.x), bflo(o.y), bfhi(o.y)}; v1 += (f32x4){bflo(o.z), bfhi(o.z), bflo(o.w), bfhi(o.w)}; }
                    if (nb == 2) { u32x2 o8; o8.x = pk_fp8x4(v0 * MG_SCALE); o8.y = pk_fp8x4(v1 * MG_SCALE); *(u32x2*)(MG8 + ro + bj * 128) = o8; }
                    else { u32x4 o2; o2.x = cvt_pk_bf16(v0[0], v0[1]); o2.y = cvt_pk_bf16(v0[2], v0[3]); o2.z = cvt_pk_bf16(v1[0], v1[1]); o2.w = cvt_pk_bf16(v1[2], v1[3]); *(u32x4*)(MG + ro + bj * 128) = o2; } } }
        }
    }
};
struct EpiOut {
    static constexpr bool PERM = true; const float* xlat; const float* xctx; const bf16_t* xb16; const float* mod; bf16_t* XA;
    __device__ __forceinline__ void operator()(const AccT& acc, const pg8::Unit& u, int wr, int wc, int fr, int fq, const float fs) const {
        const int row0 = u.pm * 256 + wr * 64 + fr, col0 = u.pn * 256 + wc * 32 + 8 * fq; const bool isc = (u.pm == 0);
        const float* gv = mod + (isc ? ADA : 0) + 2 * DM + col0;
        f32x4 g[2][2];
#pragma unroll
        for (int bj = 0; bj < 2; ++bj)
#pragma unroll
            for (int n = 0; n < 2; ++n) g[bj][n] = *(const f32x4*)(gv + bj * 128 + n * 4) * fs;
        if (xb16 == nullptr) {
#pragma unroll
            for (int ai = 0; ai < 2; ++ai) {
                f32x4 xv[4][4];
#pragma unroll
                for (int m = 0; m < 4; ++m) { const int row = row0 + ai * 128 + m * 16;
                    const float* xp = (isc ? xctx + (size_t)row * DM : xlat + (size_t)(row - CTX) * DM) + col0;
#pragma unroll
                    for (int q = 0; q < 4; ++q) xv[m][q] = *(const f32x4*)(xp + (q >> 1) * 128 + (q & 1) * 4); }
#pragma unroll
                for (int m = 0; m < 4; ++m) { bf16_t* op = XA + (size_t)(row0 + ai * 128 + m * 16) * DM + col0;
#pragma unroll
                    for (int bj = 0; bj < 2; ++bj) *(u32x4*)(op + bj * 128) = pack8(xv[m][2 * bj] + g[bj][0] * acc[ai][bj][m][0], xv[m][2 * bj + 1] + g[bj][1] * acc[ai][bj][m][1]); }
            }
        } else {
#pragma unroll
            for (int ai = 0; ai < 2; ++ai) {
                u32x4 xr[4][2];
#pragma unroll
                for (int m = 0; m < 4; ++m) { const bf16_t* xp = xb16 + (size_t)(row0 + ai * 128 + m * 16) * DM + col0;
#pragma unroll
                    for (int bj = 0; bj < 2; ++bj) xr[m][bj] = *(const u32x4*)(xp + bj * 128); }
#pragma unroll
                for (int m = 0; m < 4; ++m) { bf16_t* op = XA + (size_t)(row0 + ai * 128 + m * 16) * DM + col0;
#pragma unroll
                    for (int bj = 0; bj < 2; ++bj) { const u32x4 x = xr[m][bj];
                        *(u32x4*)(op + bj * 128) = pack8((f32x4){bflo(x.x), bfhi(x.x), bflo(x.y), bfhi(x.y)} + g[bj][0] * acc[ai][bj][m][0], (f32x4){bflo(x.z), bfhi(x.z), bflo(x.w), bfhi(x.w)} + g[bj][1] * acc[ai][bj][m][1]); } }
            }
        }
    }
};
struct EpiMoe1 {
    static constexpr bool PERM = true; unsigned char* ACT;
    __device__ __forceinline__ void operator()(const AccT& acc, const pg8::Unit& u, int wr, int wc, int fr, int fq, const float fs) const {
        const int row0 = u.pm * 256 + wr * 64 + fr, col0 = u.pn * 128 + wc * 32 + 8 * fq;
#pragma unroll
        for (int ai = 0; ai < 2; ++ai) { if (ai == 1 && u.half) break;
#pragma unroll
            for (int m = 0; m < 4; ++m) { u32x2 o;
                { const f32x4 gt = acc[ai][0][m][0] * fs, up = acc[ai][1][m][0] * (fs * ACT_SCALE); o.x = pk_fp8x4(gt * sig4(gt) * up); }
                { const f32x4 gt = acc[ai][0][m][1] * fs, up = acc[ai][1][m][1] * (fs * ACT_SCALE); o.y = pk_fp8x4(gt * sig4(gt) * up); }
                *(u32x2*)(ACT + (size_t)(row0 + ai * 128 + m * 16) * FFD + col0) = o; } }
    }
};
struct EpiMoe2 {
    static constexpr bool PERM = true; bf16_t* Y;
    __device__ __forceinline__ void operator()(const AccT& acc, const pg8::Unit& u, int wr, int wc, int fr, int fq, const float fs) const {
        const int row0 = u.pm * 256 + wr * 64 + fr, col0 = u.pn * 256 + wc * 32 + 8 * fq;
#pragma unroll
        for (int ai = 0; ai < 2; ++ai) { if (ai == 1 && u.half) break;
#pragma unroll
            for (int m = 0; m < 4; ++m) { bf16_t* rowp = Y + (size_t)(row0 + ai * 128 + m * 16) * DM + col0;
#pragma unroll
                for (int bj = 0; bj < 2; ++bj) *(u32x4*)(rowp + bj * 128) = pack8(acc[ai][bj][m][0] * fs, acc[ai][bj][m][1] * fs); } }
    }
};

#define TAIL_FILL(k, nbusy_) do { const int nbz_ = (nbusy_); unsigned* dn_ = (unsigned*)(ws + WS_CTL) + CW_DONE + 64 * (l * 8 + (k)); \
    if (nbz_ != 0) { if (bx < nbz_) { if (threadIdx.x == 0) __hip_atomic_fetch_add(dn_, 1u, __ATOMIC_RELAXED, __HIP_MEMORY_SCOPE_AGENT); } else cvt_queue(ap, lds, MOE_TILES, 1 << 30, dn_, (unsigned)nbz_); } } while (0)
#ifndef TF_P2
#define TF_P2 1
#endif
#ifndef TF_P45
#define TF_P45 1
#endif
constexpr int NPHASE = 20;
__global__ void __launch_bounds__(NTHR, 2) mk_fwd(Args args) {
    extern __shared__ __attribute__((aligned(16))) unsigned char lds_raw[];
    LAS unsigned char* ldsL = (LAS unsigned char*)lds_raw; char* lds = (char*)lds_raw;
    volatile LAS unsigned* MISC = (volatile LAS unsigned*)(ldsL + MISC_OFF);
    const int tid = threadIdx.x;
    if (tid < 32) MISC[tid] = 0u;
    __syncthreads();
    XcdBarrier bar; const int lo = args.ph_lo, hi = args.ph_hi; { unsigned char* ws = args.ws; bar.bar = (unsigned*)(ws + WS_CTL) + CW_BAR + args.li * XCD_BAR_WORDS; bar.x = 0; bar.st = nullptr;
    if (hi - lo > 1) bar = xcd_barrier_post((unsigned*)(ws + WS_CTL) + CW_BAR + args.li * XCD_BAR_WORDS, MISC + 8); }
#ifndef PH_MASK
#define PH_MASK 0xFFFFFFFFu
#endif
#define PHK(k) (((k) == 0) ? 0 : ((k) == NPHASE - 1) ? 10 : (((k) - 1) % 9) + 1)
#define IN(k) (((PH_MASK >> PHK(k)) & 1u) && lo <= (k) && (k) < hi)
#define SEAM(k) do { if (IN(k) && IN((k) + 1)) xcd_barrier(bar); } while (0)
#ifndef REPEAT_MASK
#define REPEAT_MASK 0u
#endif
#define NREP(bit) ((((REPEAT_MASK) >> (bit)) & 1u) ? 2 : 1)
#define REPB(bit) for (int rep_ = 0; rep_ < NREP(bit); ++rep_, (rep_ < NREP(bit) ? xcd_barrier(bar) : (void)0))

    REPB(0) if (IN(0)) { KArgs ap = (KArgs)__builtin_amdgcn_kernarg_segment_ptr(); asm volatile("" : "+s"(ap)); p0_prologue(ap, lds); }
    SEAM(0);

#define LAUNDER() KArgs ap = (KArgs)__builtin_amdgcn_kernarg_segment_ptr(); int l = l_; asm volatile("" : "+s"(ap), "+s"(l)); const int G = gridDim.x, bx = blockIdx.x; unsigned char* const ws = ap->ws; (void)G; (void)bx; (void)ws
    for (int l_ = 0; l_ < DEPTH; ++l_) {
        const int pb = 1 + 9 * l_;
        REPB(1) if (IN(pb + 0)) { LAUNDER(); p1_norm1(ap, l, lds); }
        SEAM(pb + 0);
        REPB(2) if (IN(pb + 1)) { LAUNDER();
            SchedDense S{TOK / 256, 40, (TOK / 256) * 40, G, bx, (const char*)(ws + WS_H8), (const char*)(ws + WS_WIN) + (size_t)l * INW * DM * 2, (size_t)256 * DM, (size_t)256 * DM * 2, 0, 1 << 20, 0};
            EpiP E{(bf16_t*)(ws + WS_P)};
            pg8::gemm_phase<EpiP, SchedDense, false, true>(ldsL, pg8::Gemm{DM, DM * 2, DM, E8M0_W, E8M0_ONE}, S, E);
            if (TF_P2) TAIL_FILL(0, S.nwg % G);
        }
        SEAM(pb + 1);
        REPB(3) if (IN(pb + 2)) { LAUNDER(); p2b_post(ap, l, lds); }
        SEAM(pb + 2);
#if PROBE_P2B
        if (IN(pb + 2)) { LAUNDER(); probe_p2b(ap, l); }
        SEAM(pb + 2);
#endif
        REPB(4) if (IN(pb + 3)) { LAUNDER();
            const bf16_t* QG = (const bf16_t*)(ws + WS_QG); const bf16_t* QW = (const bf16_t*)(ws + WS_QW);
            const bf16_t* KG = (const bf16_t*)(ws + WS_KG); const bf16_t* VG = (const bf16_t*)(ws + WS_VG);
            const bf16_t* KW = (const bf16_t*)(ws + WS_KW); const bf16_t* VW = (const bf16_t*)(ws + WS_VW);
            unsigned char* Y1 = ws + WS_YB + YB_STRIDE * 2; unsigned char* Y2b = ws + WS_YB + 2 * YB_STRIDE * 2;
            const int nitem = (l == 0) ? 264 : 256;
#ifndef P3_PARTS
#define P3_PARTS 7
#endif
            float mfix;
            { const float* qg_ = ap->in[I_QNG] + l * HD; const float* kg_ = ap->in[I_KNG] + l * HD; float a = 0.f, b = 0.f;
              for (int d = 0; d < HD; ++d) { a = fmaxf(a, fabsf(qg_[d])); b = fmaxf(b, fabsf(kg_[d])); }
              mfix = 1.03f * (float)HD * a * b; }
            if (P3_PARTS & 1) for (int it = bx; it < nitem; it += G) {
                const int h = it & 7, kvh = h >> 2; const bool isc = it >= 256; const int q0 = isc ? 0 : (it >> 3) * 256; const size_t r0 = isc ? 0 : (size_t)(CTX + q0);
                att8::attn8_body<0>(ws + WS_Q8G + r0 * MIXW + h * HD, ws + WS_K8G + kvh * HD, ws + WS_VTG + kvh * 8192, Y1 + r0 * MIXW + h * HD, isc ? 4 : TOK / 64, 0, q0, 0.f, lds);
            }
            if (P3_PARTS & 2) for (int it = bx; it < nitem; it += G) {
                const int h = it & 7, kvh = h >> 2; const bool isc = it >= 256; const int q0 = isc ? 0 : (it >> 3) * 256; const size_t r0 = isc ? 0 : (size_t)(CTX + q0);
                att8::attn8_body<1>(ws + WS_Q8W + r0 * MIXW + h * HD, ws + WS_K8W + kvh * HD, ws + WS_VTW + kvh * 8192, Y2b + r0 * MIXW + h * HD, isc ? 4 : 12, 4, q0, ap->in[I_SINK][l * 8 + h], lds);
            }
            SchedPool S{G, bx - 8, (const char*)(ws + WS_DP), (const char*)(ws + WS_POOL) + (size_t)l * 4 * 256 * 256 * 2};
            EpiPool E{ws + WS_YB, ap->in[I_POOLS] + (size_t)l * MIXW};
            if (P3_PARTS & 4) pg8::gemm_phase<EpiPool, SchedPool>(ldsL, pg8::Gemm{MIXW, 256, 256}, S, E);
            if (G == 256) { unsigned* dn_ = (unsigned*)(ws + WS_CTL) + CW_DONE + 64 * (l * 8 + 5);
                if (bx >= 8 && bx < 140) { if (threadIdx.x == 0) __hip_atomic_fetch_add(dn_, 1u, __ATOMIC_RELAXED, __HIP_MEMORY_SCOPE_AGENT); } else cvt_queue(ap, lds, MOE_TILES, 1 << 30, dn_, 132u); }
        }
        SEAM(pb + 3);
#if PROBE_ATTN
        if (IN(pb + 3)) { LAUNDER(); probe_attn(ap, l, lds); }
        SEAM(pb + 3);
#endif
        REPB(5) if (IN(pb + 4)) { LAUNDER();
            SchedMerge S{(l == 0) ? 264 : 256, G, bx, (const char*)(ws + WS_YB), (const char*)(ws + WS_WBR) + (size_t)l * 3 * DM * MIXW * 2, 3, 0, 1};
            EpiMerge E{(const bf16_t*)(ws + WS_P), (bf16_t*)(ws + WS_MG), ws + WS_MG8};
            pg8::gemm_phase<EpiMerge, SchedMerge, false, true>(ldsL, pg8::Gemm{MIXW, MIXW, MIXW, E8M0_W, E8M0_W}, S, E);
            if (TF_P45) TAIL_FILL(1, S.npos % G);
        }
        SEAM(pb + 4);
        REPB(6) if (IN(pb + 5)) { LAUNDER(); const float* mod = (const float*)(ws + WS_MOD) + (size_t)l * 2 * ADA;
            SchedOut S{(l == 0) ? 264 : 256, G, bx, (const char*)(ws + WS_MG8), (const char*)(ws + WS_WOUT) + (size_t)l * DM * DM * 2};
            EpiOut E{ap->in[I_X], ap->in[I_CTX], l == 0 ? (const bf16_t*)nullptr : (const bf16_t*)(ws + WS_XB), mod, (bf16_t*)(ws + WS_XA)};
            pg8::gemm_phase<EpiOut, SchedOut, false, true>(ldsL, pg8::Gemm{DM, DM, DM, E8M0_W, E8M0_MG}, S, E);
            if (TF_P45) TAIL_FILL(2, S.npos % G);
        }
        SEAM(pb + 5);
        REPB(7) if (IN(pb + 6)) { LAUNDER(); p6_norm2_route(ap, l, lds); cvt_queue(ap, lds, DENSE_TILES_L + (l + 1) * MOE_TILES_L, 1 << 30, nullptr, 0u); }
        SEAM(pb + 6);
        REPB(8) if (IN(pb + 7)) { LAUNDER();
            moe_tile_table(ap, l, lds);
            SchedMoe S{G, bx, (const int*)(lds + AUX_OFF + 4096), (const char*)(ws + WS_H2), (const char*)(ws + WS_WGU) + (size_t)l * NEXP * 2048 * DM, (size_t)0, (size_t)2048 * DM, (size_t)256 * DM, (const unsigned*)(ws + WS_XS)};
            EpiMoe1 E{(unsigned char*)(ws + WS_ACT)};
            pg8::gemm_phase<EpiMoe1, SchedMoe, true, true>(ldsL, pg8::Gemm{DM, DM, DM, E8M0_W, E8M0_ONE}, S, E);
        }
        SEAM(pb + 7);
        REPB(9) if (IN(pb + 8)) { LAUNDER();
            moe_tile_table(ap, l, lds);
            SchedMoe S{G, bx, (const int*)(lds + AUX_OFF + 4096), (const char*)(ws + WS_ACT), (const char*)(ws + WS_WD) + (size_t)l * NEXP * DM * FFD, (size_t)256 * FFD, (size_t)DM * FFD, (size_t)256 * FFD, nullptr};
            EpiMoe2 E{(bf16_t*)(ws + WS_Y2)};
            pg8::gemm_phase<EpiMoe2, SchedMoe, false, true>(ldsL, pg8::Gemm{FFD, 128, FFD, E8M0_W, E8M0_ACT, 32768}, S, E);
        }
        SEAM(pb + 8);
    }
    REPB(10) if (IN(NPHASE - 1)) { KArgs ap = (KArgs)__builtin_amdgcn_kernarg_segment_ptr(); asm volatile("" : "+s"(ap)); p_final(ap, lds); }
#undef IN
#undef SEAM
}

extern "C" void kernel_launch(void* const* d_in, const int* in_sizes, int n_in, void* d_out, int out_size, void* d_ws, size_t ws_size, hipStream_t stream) {
    static int grid = 0;
    if (grid == 0) {
        if (n_in != 22 || out_size != SEQ * DM || ws_size < WS_END) { fprintf(stderr, "kernel_launch: shape/workspace mismatch (n_in %d out %d ws %zu need %zu)\n", n_in, out_size, ws_size, (size_t)WS_END); grid = -1; return; }
        int dev = 0, cus = 0, per_cu = 0;
        if (hipGetDevice(&dev) != hipSuccess || hipDeviceGetAttribute(&cus, hipDeviceAttributeMultiprocessorCount, dev) != hipSuccess) { grid = -1; return; }
        if (hipFuncSetAttribute((const void*)mk_fwd, hipFuncAttributeMaxDynamicSharedMemorySize, LDS_BYTES) != hipSuccess) { fprintf(stderr, "kernel_launch: hipFuncSetAttribute failed\n"); grid = -1; return; }
        if (hipOccupancyMaxActiveBlocksPerMultiprocessor(&per_cu, (const void*)mk_fwd, NTHR, LDS_BYTES) != hipSuccess || per_cu < 1) { fprintf(stderr, "kernel_launch: occupancy query reports %d\n", per_cu); per_cu = 1; }
        (void)hipGetLastError();
        grid = cus;
        if (grid > 256) grid = 256;
    }
    if (grid < 0) return;
    (void)hipMemsetAsync((char*)d_ws + WS_CTL, 0, CTL_ZERO_BYTES, stream);
    Args a{};
    for (int i = 0; i < 22; ++i) a.in[i] = (const float*)d_in[i];
    a.out = (float*)d_out; a.ws = (unsigned char*)d_ws; a.pad = 0;
#if MK_PER_PHASE
    for (int p = 0; p < NPHASE; ++p) { a.ph_lo = p; a.ph_hi = p + 1; a.li = 0; hipLaunchKernelGGL(mk_fwd, dim3(grid), dim3(NTHR), LDS_BYTES, stream, a); }
#else
    a.ph_lo = 0; a.ph_hi = NPHASE; a.li = 0;
    hipLaunchKernelGGL(mk_fwd, dim3(grid), dim3(NTHR), LDS_BYTES, stream, a);
#endif
    const hipError_t le = hipPeekAtLastError();
    if (le != hipSuccess) fprintf(stderr, "kernel_launch: launch failed: %s\n", hipGetErrorName(le));
}
```
